# Optimizing an MI355X kernel written in HIP

```python
import math
import jax
import jax.numpy as jnp
from jax import lax
import numpy as np

D_MODEL = 1024
BATCH = 8
SEQ = 4096
DEPTH = 4

CTX_LEN = 256
GRID_W = 64
HEAD_DIM = 64
ROPE_BASE = 10000.0
N_MOD = 9
FFN_DIM = 2816
A_HEADS = 4
A_VDIM = 2 * HEAD_DIM
B_HEADS = 4
B_KDIM = 64
B_VDIM = 128
GATE_RANK = 16
GATE_TAU = 16.0
GLA_CHUNK = 64
C_HEADS = 8
C_KV_HEADS = 2
WINDOW = 128
Q_BLOCK = 128
KEY_SPAN = Q_BLOCK + 2 * WINDOW
NEG_INF = -1e30
MIX_SIZES = (A_HEADS * 2 * HEAD_DIM, A_HEADS * 2 * HEAD_DIM, A_HEADS * A_VDIM,
             B_HEADS * B_KDIM, B_HEADS * B_KDIM, B_HEADS * B_VDIM, 2 * GATE_RANK, B_HEADS * B_VDIM,
             C_HEADS * HEAD_DIM, C_KV_HEADS * HEAD_DIM, C_KV_HEADS * HEAD_DIM, 3 * D_MODEL)
IN_COLS = sum(MIX_SIZES)
SPLITS = tuple(int(s) for s in np.cumsum(MIX_SIZES)[:-1])

kernel_name = 'hybrid_prefix_dit_block'


def _rmsnorm(x, g, eps=1e-6):
    xf = x.astype(jnp.float32)
    y = xf * lax.rsqrt(jnp.mean(xf * xf, axis=-1, keepdims=True) + eps)
    return (y * g.astype(jnp.float32)).astype(x.dtype)


def _modulate(h, shift, scale):
    return h * (1.0 + scale) + shift


def _swiglu(h, w_up, w_down):
    u, v = jnp.split(h @ w_up, 2, axis=-1)
    return (jax.nn.silu(u) * v) @ w_down


def _rope_tables(n_tok):
    rows = n_tok // GRID_W
    row = jnp.repeat(jnp.arange(rows, dtype=jnp.float32), GRID_W)
    col = jnp.tile(jnp.arange(GRID_W, dtype=jnp.float32), rows)
    n_freq = HEAD_DIM // 4
    freqs = jnp.power(ROPE_BASE, -jnp.arange(n_freq, dtype=jnp.float32) / n_freq)
    ar = row[:, None] * freqs
    ac = col[:, None] * freqs
    ang = jnp.concatenate([ar, ar, ac, ac], axis=-1)
    return jnp.cos(ang), jnp.sin(ang)


def _apply_rope(x, cos, sin):
    bshape = (x.shape[1],) + (1,) * (x.ndim - 3) + (HEAD_DIM,)
    cos = cos.reshape(bshape)
    sin = sin.reshape(bshape)
    xs = x.reshape(x.shape[:-1] + (2, 2, HEAD_DIM // 4))
    rot = jnp.concatenate([-xs[..., 1:, :], xs[..., :1, :]], axis=-2).reshape(x.shape)
    return (x * cos + rot * sin).astype(x.dtype)


def _diff_attend(q, k, v, lam):
    s = jnp.einsum('bqhmd,bkhmd->bhmqk', q, k).astype(jnp.float32) * (HEAD_DIM ** -0.5)
    p = jax.nn.softmax(s, axis=-1)
    a = p[:, :, 0] - lam * p[:, :, 1]
    return jnp.einsum('bhqk,bkhe->bqhe', a.astype(v.dtype), v)


def _diff_attention_latent(q, k_all, v_all, lam):
    bsz, n = q.shape[:2]
    nb = n // Q_BLOCK
    qb = jnp.moveaxis(q.reshape(bsz, nb, Q_BLOCK, A_HEADS, 2, HEAD_DIM), 1, 0)
    o = lax.map(lambda blk: _diff_attend(blk, k_all, v_all, lam), qb)
    return jnp.moveaxis(o, 0, 1).reshape(bsz, n, A_HEADS, A_VDIM)


def _gla_inputs(p, gate_w, gate_b):
    bsz, n = p[3].shape[:2]

    def heads(t, dh):
        return t.reshape(bsz, n, B_HEADS, dh).transpose(0, 2, 1, 3).astype(jnp.float32)

    q = heads(p[3], B_KDIM)
    k = heads(p[4], B_KDIM)
    v = heads(p[5], B_VDIM)
    log_a = []
    for d in range(2):
        z = p[6][..., d * GATE_RANK:(d + 1) * GATE_RANK] @ gate_w[d] + gate_b[d]
        log_a.append(heads(jax.nn.log_sigmoid(z.astype(jnp.float32)) / GATE_TAU, B_KDIM))
    return q, k, v, log_a


def _gla_states(k, v, log_a, s0):
    bsz, h, n, dk = k.shape
    nc = n // GLA_CHUNK
    kc = k.reshape(bsz, h, nc, GLA_CHUNK, dk)
    vc = v.reshape(bsz, h, nc, GLA_CHUNK, B_VDIM)
    cum = jnp.cumsum(log_a.reshape(bsz, h, nc, GLA_CHUNK, dk), axis=3)
    last = cum[:, :, :, -1]
    kv = jnp.einsum('bhnck,bhncv->bhnkv', kc * jnp.exp(last[:, :, :, None] - cum), vc)

    def step(state, inp):
        dec, upd = inp
        return dec[..., None] * state + upd, state

    final, starts = lax.scan(step, s0, (jnp.moveaxis(jnp.exp(last), 2, 0), jnp.moveaxis(kv, 2, 0)))
    return cum, jnp.moveaxis(starts, 0, 2), final


def _gla_outputs(q, k, v, cum, starts):
    bsz, h, n, dk = q.shape
    nc = n // GLA_CHUNK
    qe = q.reshape(bsz, h, nc, GLA_CHUNK, dk) * (dk ** -0.5) * jnp.exp(cum)
    ke = k.reshape(bsz, h, nc, GLA_CHUNK, dk) * jnp.exp(-cum)
    vc = v.reshape(bsz, h, nc, GLA_CHUNK, B_VDIM)
    idx = jnp.arange(GLA_CHUNK)
    earlier = idx[:, None] >= idx[None, :]
    att = jnp.where(earlier, jnp.einsum('bhnik,bhnjk->bhnij', qe, ke), 0.0)
    o = jnp.einsum('bhnij,bhnjv->bhniv', att, vc) + jnp.einsum('bhnik,bhnkv->bhniv', qe, starts)
    return o.reshape(bsz, h, n, B_VDIM)


def _gla_direction(lat, ctx_in, la_lat, la_ctx, reverse, with_ctx):
    q, k, v = lat
    qc, kc, vc = ctx_in
    if reverse:
        q, k, v, la_lat, qc, kc, vc, la_ctx = [jnp.flip(t, axis=2) for t in (q, k, v, la_lat, qc, kc, vc, la_ctx)]
    s0 = jnp.zeros(k.shape[:2] + (B_KDIM, B_VDIM), jnp.float32)
    cum_c, starts_c, final_c = _gla_states(kc, vc, la_ctx, s0)
    cum, starts, _ = _gla_states(k, v, la_lat, final_c)
    o = _gla_outputs(q, k, v, cum, starts)
    o_c = _gla_outputs(qc, kc, vc, cum_c, starts_c) if with_ctx else None
    if reverse:
        o = jnp.flip(o, axis=2)
        o_c = jnp.flip(o_c, axis=2) if with_ctx else None
    return o, o_c


def _window_attention_latent(q, k, v, k_ctx, v_ctx, sink):
    bsz, n = q.shape[:2]
    nb = n // Q_BLOCK
    g = C_HEADS // C_KV_HEADS
    n_ctx = k_ctx.shape[1]
    qb = jnp.moveaxis(q.reshape(bsz, nb, Q_BLOCK, C_KV_HEADS, g, HEAD_DIM), 1, 0)
    pad = ((0, 0), (WINDOW, WINDOW), (0, 0), (0, 0))
    kp = jnp.pad(k, pad)
    vp = jnp.pad(v, pad)
    sink_row = jnp.broadcast_to(sink.astype(jnp.float32).reshape(1, C_KV_HEADS, g, 1, 1),
                                (bsz, C_KV_HEADS, g, Q_BLOCK, 1))
    qi = jnp.arange(Q_BLOCK)[:, None]
    kj = jnp.arange(KEY_SPAN)[None, :]
    rel = kj - qi
    scale = HEAD_DIM ** -0.5

    def one_block(args):
        blk, qblk = args
        kb = lax.dynamic_slice_in_dim(kp, blk * Q_BLOCK, KEY_SPAN, axis=1)
        vb = lax.dynamic_slice_in_dim(vp, blk * Q_BLOCK, KEY_SPAN, axis=1)
        pos = blk * Q_BLOCK - WINDOW + kj
        valid = (rel >= 0) & (rel <= 2 * WINDOW) & (pos >= 0) & (pos < n)
        s_loc = jnp.einsum('bqhgd,bkhd->bhgqk', qblk, kb).astype(jnp.float32) * scale
        s_loc = jnp.where(valid, s_loc, NEG_INF)
        s_ctx = jnp.einsum('bqhgd,bkhd->bhgqk', qblk, k_ctx).astype(jnp.float32) * scale
        p = jax.nn.softmax(jnp.concatenate([s_loc, s_ctx, sink_row], axis=-1), axis=-1).astype(v.dtype)
        return (jnp.einsum('bhgqk,bkhd->bqhgd', p[..., :KEY_SPAN], vb)
                + jnp.einsum('bhgqk,bkhd->bqhgd', p[..., KEY_SPAN:KEY_SPAN + n_ctx], v_ctx))

    o = lax.map(one_block, (jnp.arange(nb), qb))
    return jnp.moveaxis(o, 0, 1).reshape(bsz, n, C_HEADS * HEAD_DIM)


def _window_attention_ctx(q, k, v, sink):
    bsz, n = q.shape[:2]
    g = C_HEADS // C_KV_HEADS
    qg = q.reshape(bsz, n, C_KV_HEADS, g, HEAD_DIM)
    s = jnp.einsum('bqhgd,bkhd->bhgqk', qg, k).astype(jnp.float32) * (HEAD_DIM ** -0.5)
    sink_row = jnp.broadcast_to(sink.astype(jnp.float32).reshape(1, C_KV_HEADS, g, 1, 1), (bsz, C_KV_HEADS, g, n, 1))
    p = jax.nn.softmax(jnp.concatenate([s, sink_row], axis=-1), axis=-1)[..., :n].astype(v.dtype)
    return jnp.einsum('bhgqk,bkhd->bqhgd', p, v).reshape(bsz, n, C_HEADS * HEAD_DIM)


def _token_mix(hx, hc, w_in, diff_lambda, diff_subln, gla_gate_w, gla_gate_b, gla_norm, swa_sink,
               w_br_a, w_br_b, w_br_c, w_out, lam_init, cos, sin, with_ctx):
    bsz, n, _ = hx.shape
    n_ctx = hc.shape[1]
    px = jnp.split(hx @ w_in, SPLITS, axis=-1)
    pc = jnp.split(hc @ w_in, SPLITS, axis=-1)

    aq = _apply_rope(px[0].reshape(bsz, n, A_HEADS, 2, HEAD_DIM), cos, sin)
    ak = _apply_rope(px[1].reshape(bsz, n, A_HEADS, 2, HEAD_DIM), cos, sin)
    av = px[2].reshape(bsz, n, A_HEADS, A_VDIM)
    caq = pc[0].reshape(bsz, n_ctx, A_HEADS, 2, HEAD_DIM)
    cak = pc[1].reshape(bsz, n_ctx, A_HEADS, 2, HEAD_DIM)
    cav = pc[2].reshape(bsz, n_ctx, A_HEADS, A_VDIM)
    lp = diff_lambda.astype(jnp.float32)
    lam = jnp.exp(jnp.sum(lp[0] * lp[1])) - jnp.exp(jnp.sum(lp[2] * lp[3])) + lam_init

    def diff_out(o):
        return (_rmsnorm(o, diff_subln) * (1.0 - lam_init)).reshape(o.shape[0], o.shape[1], A_HEADS * A_VDIM)

    o_a = diff_out(_diff_attention_latent(aq, jnp.concatenate([ak, cak], axis=1),
                                          jnp.concatenate([av, cav], axis=1), lam))

    q, k, v, la = _gla_inputs(px, gla_gate_w, gla_gate_b)
    qc, kc, vc, lac = _gla_inputs(pc, gla_gate_w, gla_gate_b)
    of, ofc = _gla_direction((q, k, v), (qc, kc, vc), la[0], lac[0], False, with_ctx)
    ob, obc = _gla_direction((q, k, v), (qc, kc, vc), la[1], lac[1], True, with_ctx)

    def gla_out(o, r):
        o = _rmsnorm(o.transpose(0, 2, 1, 3), gla_norm)
        return o.reshape(o.shape[0], o.shape[1], B_HEADS * B_VDIM).astype(r.dtype) * jax.nn.silu(r)

    o_b = gla_out(of + ob, px[7])

    cq = _apply_rope(px[8].reshape(bsz, n, C_HEADS, HEAD_DIM), cos, sin)
    ck = _apply_rope(px[9].reshape(bsz, n, C_KV_HEADS, HEAD_DIM), cos, sin)
    cv = px[10].reshape(bsz, n, C_KV_HEADS, HEAD_DIM)
    ccq = pc[8].reshape(bsz, n_ctx, C_HEADS, HEAD_DIM)
    cck = pc[9].reshape(bsz, n_ctx, C_KV_HEADS, HEAD_DIM)
    ccv = pc[10].reshape(bsz, n_ctx, C_KV_HEADS, HEAD_DIM)
    o_c = _window_attention_latent(cq, ck, cv, cck, ccv, swa_sink)

    def merge(gate_cols, oa, obr, oc):
        ga, gb, gc = jnp.split(jax.nn.sigmoid(gate_cols), 3, axis=-1)
        y = ga * (oa @ w_br_a) + gb * (obr @ w_br_b) + gc * (oc @ w_br_c)
        return y @ w_out

    out_x = merge(px[11], o_a, o_b, o_c)
    if not with_ctx:
        return out_x, None
    oa_c = diff_out(_diff_attend(caq, cak, cav, lam))
    ob_c = gla_out(ofc + obc, pc[7])
    oc_c = _window_attention_ctx(ccq, cck, ccv, swa_sink)
    return out_x, merge(pc[11], oa_c, ob_c, oc_c)


def setup_inputs(seed: int = 0) -> dict:
    key = jax.random.key(seed)
    ks = jax.random.split(key, 24)
    f32 = jnp.float32
    D = D_MODEL
    L = DEPTH

    def nrm(k, shape, scale):
        return jax.random.normal(k, shape, f32) * scale

    return {
        'x': nrm(ks[0], (BATCH, SEQ, D), 1.0),
        'c': nrm(ks[1], (BATCH, D), 1.0),
        'ctx': nrm(ks[2], (BATCH, CTX_LEN, D), 1.0),
        'c_ctx': nrm(ks[3], (D,), 1.0),
        'w_ada': nrm(ks[4], (L, D, N_MOD * D), 0.3 * D ** -0.5),
        'b_ada': nrm(ks[5], (L, N_MOD * D), 0.02),
        'norm_g': 1.0 + nrm(ks[6], (L, 3, D), 0.02),
        'w_ffn1_in': nrm(ks[7], (L, D, 2 * FFN_DIM), D ** -0.5),
        'w_ffn1_out': nrm(ks[8], (L, FFN_DIM, D), FFN_DIM ** -0.5),
        'w_ffn2_in': nrm(ks[9], (L, D, 2 * FFN_DIM), D ** -0.5),
        'w_ffn2_out': nrm(ks[10], (L, FFN_DIM, D), FFN_DIM ** -0.5),
        'w_mix_in': nrm(ks[11], (L, D, IN_COLS), D ** -0.5),
        'diff_lambda': nrm(ks[12], (L, 4, HEAD_DIM), 0.1),
        'diff_subln': 1.0 + nrm(ks[13], (L, A_VDIM), 0.02),
        'gla_gate_w': nrm(ks[14], (L, 2, GATE_RANK, B_HEADS * B_KDIM), GATE_RANK ** -0.5),
        'gla_gate_b': nrm(ks[15], (L, 2, B_HEADS * B_KDIM), 0.1),
        'gla_norm': 1.0 + nrm(ks[16], (L, B_VDIM), 0.02),
        'swa_sink': nrm(ks[17], (L, C_HEADS), 0.5),
        'w_br_a': nrm(ks[18], (L, A_HEADS * A_VDIM, D), (A_HEADS * A_VDIM) ** -0.5),
        'w_br_b': nrm(ks[19], (L, B_HEADS * B_VDIM, D), (B_HEADS * B_VDIM) ** -0.5),
        'w_br_c': nrm(ks[20], (L, C_HEADS * HEAD_DIM, D), (C_HEADS * HEAD_DIM) ** -0.5),
        'w_mix_out': nrm(ks[21], (L, D, D), D ** -0.5),
        'final_g': 1.0 + nrm(ks[22], (D,), 0.02),
    }


def reference(x, c, ctx, c_ctx, w_ada, b_ada, norm_g, w_ffn1_in, w_ffn1_out, w_ffn2_in, w_ffn2_out,
              w_mix_in, diff_lambda, diff_subln, gla_gate_w, gla_gate_b, gla_norm, swa_sink,
              w_br_a, w_br_b, w_br_c, w_mix_out, final_g):
    bsz, n, d = x.shape
    cos, sin = _rope_tables(n)
    sc = jax.nn.silu(c)
    scc = jax.nn.silu(c_ctx)
    for l in range(DEPTH):
        with_ctx = l < DEPTH - 1
        lam_init = 0.8 - 0.6 * math.exp(-0.3 * l)
        mx = (sc @ w_ada[l] + b_ada[l]).reshape(bsz, N_MOD, 1, d)
        mc = (scc @ w_ada[l] + b_ada[l]).reshape(N_MOD, d)
        mx = [mx[:, i] for i in range(N_MOD)]
        mc = [mc[i] for i in range(N_MOD)]
        x = x + 0.5 * mx[2] * _swiglu(_modulate(_rmsnorm(x, norm_g[l, 0]), mx[0], mx[1]), w_ffn1_in[l], w_ffn1_out[l])
        ctx = ctx + 0.5 * mc[2] * _swiglu(_modulate(_rmsnorm(ctx, norm_g[l, 0]), mc[0], mc[1]), w_ffn1_in[l], w_ffn1_out[l])
        hx = _modulate(_rmsnorm(x, norm_g[l, 1]), mx[3], mx[4])
        hc = _modulate(_rmsnorm(ctx, norm_g[l, 1]), mc[3], mc[4])
        ox, oc = _token_mix(hx, hc, w_mix_in[l], diff_lambda[l], diff_subln[l], gla_gate_w[l], gla_gate_b[l],
                            gla_norm[l], swa_sink[l], w_br_a[l], w_br_b[l], w_br_c[l], w_mix_out[l],
                            lam_init, cos, sin, with_ctx)
        x = x + mx[5] * ox
        x = x + 0.5 * mx[8] * _swiglu(_modulate(_rmsnorm(x, norm_g[l, 2]), mx[6], mx[7]), w_ffn2_in[l], w_ffn2_out[l])
        if with_ctx:
            ctx = ctx + mc[5] * oc
            ctx = ctx + 0.5 * mc[8] * _swiglu(_modulate(_rmsnorm(ctx, norm_g[l, 2]), mc[6], mc[7]), w_ffn2_in[l], w_ffn2_out[l])
    return _rmsnorm(x, final_g)
```

```cpp
#include <hip/hip_runtime.h>
#include <hip/hip_cooperative_groups.h>
#include <cstdio>
namespace cg = cooperative_groups;

typedef unsigned short bf16_t;
using bf16x8 = __attribute__((ext_vector_type(8))) short;
using f32x4  = __attribute__((ext_vector_type(4))) float;
using u32x4  = __attribute__((ext_vector_type(4))) unsigned;

#define DEV __device__ __forceinline__

constexpr int D = 1024, FF = 2816, NLAT = 32768, NCTX = 2048, MROWS = 34816, DEPTH = 4;
constexpr int PBW = 3232;
constexpr int PB_AQ = 0, PB_AK = 512, PB_BQ = 1024, PB_BK = 1280, PB_BV = 1536, PB_BR = 2048, PB_CQ = 2560, PB_CK = 3072, PB_LR = 3200;
constexpr int KVLEN = 4352;
constexpr int LDS_BYTES = 143360 + 64;
constexpr int LDS_MISC = 143360;
constexpr int NTHR = 512;
constexpr int NSUB = 12;
constexpr int NPH = 1 + NSUB * DEPTH + 1;

constexpr size_t OFF_XC   = 0;
constexpr size_t OFF_H    = OFF_XC + (size_t)NCTX * D * 4;
constexpr size_t OFF_U    = OFF_H + (size_t)MROWS * D * 2;
constexpr size_t OFF_W    = OFF_U + (size_t)MROWS * PBW * 2;
constexpr size_t W_ELEMS  = 27262976;
constexpr size_t OFF_VTA  = OFF_W + W_ELEMS * 2;
constexpr size_t OFF_VTC  = OFF_VTA + (size_t)8 * 4 * 128 * KVLEN * 2;
constexpr size_t OFF_O    = OFF_VTC + (size_t)8 * 2 * 64 * KVLEN * 2;
constexpr size_t OFF_OFB  = OFF_O + (size_t)MROWS * 1536 * 2;
constexpr size_t OFF_MOD  = OFF_OFB + (size_t)2 * MROWS * 512 * 2;
constexpr size_t OFF_ROPE = OFF_MOD + (size_t)DEPTH * 9 * 9216 * 4;
constexpr size_t OFF_MISC = OFF_ROPE + 8192;
constexpr size_t OFF_BAR  = OFF_MISC + 256;
constexpr size_t OFF_Y    = OFF_BAR + 16384;
constexpr size_t OFF_BR   = OFF_Y + (size_t)MROWS * D * 2;
constexpr size_t WS_NEED  = OFF_BR + (size_t)MROWS * 512 * 2;

constexpr size_t W_UP1 = 0, W_DN1 = 5767168, W_UP2 = 8650752, W_DN2 = 14417920, W_MIX = 17301504,
                 W_G = 21495808, W_BRA = 24641536, W_BRB = 25165824, W_BRC = 25690112, W_OUT = 26214400;

struct Params {
  const float *x, *c, *ctx, *c_ctx, *w_ada, *b_ada, *norm_g, *w_ffn1_in, *w_ffn1_out, *w_ffn2_in, *w_ffn2_out,
              *w_mix_in, *diff_lambda, *diff_subln, *gla_gate_w, *gla_gate_b, *gla_norm, *swa_sink,
              *w_br_a, *w_br_b, *w_br_c, *w_mix_out, *final_g;
  float* out;
  unsigned char* ws;
  int ph_lo, ph_hi;
};

DEV int otid() { int t = threadIdx.x; asm volatile("" : "+v"(t)); return t; }
typedef __bf16 hbf16x2_t __attribute__((ext_vector_type(2)));
typedef float hf32x2_t __attribute__((ext_vector_type(2)));
DEV unsigned short f2bf(float f) { const __bf16 h = (__bf16)f; return __builtin_bit_cast(unsigned short, h); }
DEV float bf2f(unsigned short b) { return __uint_as_float(((unsigned)b) << 16); }
DEV unsigned pack2(float a, float b) { const hf32x2_t v = {a, b}; return __builtin_bit_cast(unsigned, __builtin_convertvector(v, hbf16x2_t)); }
DEV float sigmoidf_(float x) { return 1.f / (1.f + __expf(-x)); }
DEV float siluf_(float x) { return x / (1.f + __expf(-x)); }
DEV f32x4 mfma16(bf16x8 a, bf16x8 b, f32x4 c) { return __builtin_amdgcn_mfma_f32_16x16x32_bf16(a, b, c, 0, 0, 0); }
DEV int mod_bp(int m) { return m < NLAT ? (m >> 12) : 8; }
DEV float* xrow_ptr(const Params& p, int m) {
  return m < NLAT ? p.out + (size_t)m * D : (float*)(p.ws + OFF_XC) + (size_t)(m - NLAT) * D;
}

template <int NI, bool TRANS>
DEV void gemm_compute(f32x4 (&acc)[NI][8], const bf16_t* pa, const bf16_t* pb, int lr, int lg) {
#pragma unroll
  for (int ks = 0; ks < 2; ++ks) {
    bf16x8 bfr[NI];
    const int so = ((ks * 4 + lg) ^ (lr & 7)) * 8;
#pragma unroll
    for (int ni = 0; ni < NI; ++ni) bfr[ni] = *(const bf16x8*)(pb + ni * 16 * 64 + so);
#pragma unroll
    for (int mh = 0; mh < 2; ++mh) {
      bf16x8 af[4];
#pragma unroll
      for (int mi = 0; mi < 4; ++mi) af[mi] = *(const bf16x8*)(pa + (mh * 4 + mi) * 16 * 64 + so);
#pragma unroll
      for (int ni = 0; ni < NI; ++ni)
#pragma unroll
        for (int mi = 0; mi < 4; ++mi)
          acc[ni][mh * 4 + mi] = TRANS ? mfma16(bfr[ni], af[mi], acc[ni][mh * 4 + mi]) : mfma16(af[mi], bfr[ni], acc[ni][mh * 4 + mi]);
    }
  }
}

#define GL_LAS __attribute__((address_space(3)))
#define GL_BARRIER() do { asm volatile("s_waitcnt lgkmcnt(0)" ::: "memory"); __builtin_amdgcn_s_barrier(); asm volatile("" ::: "memory"); } while (0)
template <bool TRANS>
DEV void gemm_kloop_glds4(f32x4 (&acc)[4][8], const bf16_t* __restrict__ Ag, int lda, const bf16_t* __restrict__ Bg, int ldb,
                          int K, unsigned char* smem) {
  const int tid = otid(), lane = tid & 63, wave = tid >> 6, wm = wave >> 2, wn = wave & 3;
  const int lr = lane & 15, lg = lane >> 4;
  const int KT2 = K >> 5;
  const int grow = lane >> 2, gpos = lane & 3;
  const int gsw = (0x78 >> (((grow >> 2) & 3) * 2)) & 3;
  const bf16_t* asrc = Ag + (size_t)(wave * 16 + grow) * lda + ((gpos ^ gsw) * 8);
  const bf16_t* bsrc = Bg + (size_t)(wave * 16 + grow) * ldb + ((gpos ^ gsw) * 8);
  unsigned char* ldsw = smem + wave * 1024;
#define GL_TILE(J)                                                                                          \
  {                                                                                                        \
    const int st_ = (J) & 3, k0_ = (J) << 5;                                                               \
    _Pragma("unroll") for (int i = 0; i < 2; ++i) {                                                        \
      __builtin_amdgcn_global_load_lds((const unsigned*)(asrc + (size_t)(i * 128) * lda + k0_),            \
                                       (GL_LAS unsigned*)(ldsw + st_ * 32768 + i * 8192), 16, 0, 0);       \
      __builtin_amdgcn_global_load_lds((const unsigned*)(bsrc + (size_t)(i * 128) * ldb + k0_),            \
                                       (GL_LAS unsigned*)(ldsw + st_ * 32768 + 16384 + i * 8192), 16, 0, 0); \
    }                                                                                                      \
  }
  const int rsw = (0x78 >> (((lr >> 2) & 3) * 2)) & 3;
  const bf16_t* pa = (const bf16_t*)smem + (wm * 128 + lr) * 32 + ((lg ^ rsw) * 8);
  const bf16_t* pb = (const bf16_t*)(smem + 16384) + (wn * 64 + lr) * 32 + ((lg ^ rsw) * 8);
  GL_TILE(0);
  GL_TILE(1);
  GL_TILE(2);
  for (int j = 0; j < KT2; ++j) {
    if (j + 2 < KT2) asm volatile("s_waitcnt vmcnt(8)" ::: "memory");
    else if (j + 1 < KT2) asm volatile("s_waitcnt vmcnt(4)" ::: "memory");
    else asm volatile("s_waitcnt vmcnt(0)" ::: "memory");
    GL_BARRIER();
    if (j + 3 < KT2) GL_TILE(j + 3);
    const bf16_t* qa = pa + (j & 3) * 16384;
    const bf16_t* qb = pb + (j & 3) * 16384;
    bf16x8 bfr[4];
#pragma unroll
    for (int ni = 0; ni < 4; ++ni) bfr[ni] = *(const bf16x8*)(qb + ni * 16 * 32);
#pragma unroll
    for (int mh = 0; mh < 2; ++mh) {
      bf16x8 af[4];
#pragma unroll
      for (int mi = 0; mi < 4; ++mi) af[mi] = *(const bf16x8*)(qa + (mh * 4 + mi) * 16 * 32);
#pragma unroll
      for (int ni = 0; ni < 4; ++ni)
#pragma unroll
        for (int mi = 0; mi < 4; ++mi)
          acc[ni][mh * 4 + mi] = TRANS ? mfma16(bfr[ni], af[mi], acc[ni][mh * 4 + mi]) : mfma16(af[mi], bfr[ni], acc[ni][mh * 4 + mi]);
    }
  }
  GL_BARRIER();
#undef GL_TILE
}

template <bool TRANS>
DEV void gemm_kloop_glds64(f32x4 (&acc)[4][8], const bf16_t* __restrict__ Ag, int lda, const bf16_t* __restrict__ Bg, int ldb,
                           int K, unsigned char* smem, bool primed) {
  const int tid = otid(), lane = tid & 63, wave = tid >> 6, wm = wave >> 2, wn = wave & 3;
  const int lr = lane & 15, lg = lane >> 4;
  const int KT = K >> 6;
  const int grow = lane >> 3, gpos = lane & 7;
  const bf16_t* asrc = Ag + (size_t)(wave * 8 + grow) * lda + ((gpos ^ grow) * 8);
  const bf16_t* bsrc = Bg + (size_t)(wave * 8 + grow) * ldb + ((gpos ^ grow) * 8);
  unsigned char* ldsw = smem + wave * 1024;
#define GL64_TILE(J)                                                                                        \
  {                                                                                                        \
    const int st_ = (J) & 1, k0_ = (J) << 6;                                                               \
    _Pragma("unroll") for (int i = 0; i < 4; ++i) {                                                        \
      __builtin_amdgcn_global_load_lds((const unsigned*)(asrc + (size_t)(i * 64) * lda + k0_),             \
                                       (GL_LAS unsigned*)(ldsw + st_ * 65536 + i * 8192), 16, 0, 0);       \
      __builtin_amdgcn_global_load_lds((const unsigned*)(bsrc + (size_t)(i * 64) * ldb + k0_),             \
                                       (GL_LAS unsigned*)(ldsw + st_ * 65536 + 32768 + i * 8192), 16, 0, 0); \
    }                                                                                                      \
  }
  const bf16_t* pa = (const bf16_t*)smem + (wm * 128 + lr) * 64;
  const bf16_t* pb = (const bf16_t*)(smem + 32768) + (wn * 64 + lr) * 64;
  if (!primed) GL64_TILE(0);
  for (int j = 0; j < KT; ++j) {
    asm volatile("s_waitcnt vmcnt(0)" ::: "memory");
    GL_BARRIER();
    const bf16_t* qa = pa + (j & 1) * 32768;
    const bf16_t* qb = pb + (j & 1) * 32768;
    bf16x8 bf0[4], af0[8], bf1[4], af1[4];
    const int so0 = (lg ^ (lr & 7)) * 8, so1 = ((4 + lg) ^ (lr & 7)) * 8;
#pragma unroll
    for (int ni = 0; ni < 4; ++ni) bf0[ni] = *(const bf16x8*)(qb + ni * 16 * 64 + so0);
#pragma unroll
    for (int mi = 0; mi < 8; ++mi) af0[mi] = *(const bf16x8*)(qa + mi * 16 * 64 + so0);
    __builtin_amdgcn_sched_barrier(0);
    if (j + 1 < KT) GL64_TILE(j + 1);
    __builtin_amdgcn_sched_barrier(0);
#pragma unroll
    for (int ni = 0; ni < 4; ++ni) bf1[ni] = *(const bf16x8*)(qb + ni * 16 * 64 + so1);
#pragma unroll
    for (int mi = 0; mi < 4; ++mi) af1[mi] = *(const bf16x8*)(qa + mi * 16 * 64 + so1);
    __builtin_amdgcn_sched_barrier(0);
#pragma unroll
    for (int mi = 0; mi < 8; ++mi)
#pragma unroll
      for (int ni = 0; ni < 4; ++ni)
        acc[ni][mi] = TRANS ? mfma16(bf0[ni], af0[mi], acc[ni][mi]) : mfma16(af0[mi], bf0[ni], acc[ni][mi]);
    bf16x8 af2[4];
#pragma unroll
    for (int mi = 0; mi < 4; ++mi) af2[mi] = *(const bf16x8*)(qa + (4 + mi) * 16 * 64 + so1);
#pragma unroll
    for (int mi = 0; mi < 4; ++mi)
#pragma unroll
      for (int ni = 0; ni < 4; ++ni)
        acc[ni][mi] = TRANS ? mfma16(bf1[ni], af1[mi], acc[ni][mi]) : mfma16(af1[mi], bf1[ni], acc[ni][mi]);
#pragma unroll
    for (int mi = 0; mi < 4; ++mi)
#pragma unroll
      for (int ni = 0; ni < 4; ++ni)
        acc[ni][4 + mi] = TRANS ? mfma16(bf1[ni], af2[mi], acc[ni][4 + mi]) : mfma16(af2[mi], bf1[ni], acc[ni][4 + mi]);
  }
  GL_BARRIER();
#undef GL64_TILE
}

DEV void glds64_prime(const bf16_t* __restrict__ Ag, int lda, const bf16_t* __restrict__ Bg, int ldb, unsigned char* smem) {
  const int tid = otid(), lane = tid & 63, wave = tid >> 6;
  const int grow = lane >> 3, gpos = lane & 7;
  const bf16_t* asrc = Ag + (size_t)(wave * 8 + grow) * lda + ((gpos ^ grow) * 8);
  const bf16_t* bsrc = Bg + (size_t)(wave * 8 + grow) * ldb + ((gpos ^ grow) * 8);
  unsigned char* ldsw = smem + wave * 1024;
#pragma unroll
  for (int i = 0; i < 4; ++i) {
    __builtin_amdgcn_global_load_lds((const unsigned*)(asrc + (size_t)(i * 64) * lda), (GL_LAS unsigned*)(ldsw + i * 8192), 16, 0, 0);
    __builtin_amdgcn_global_load_lds((const unsigned*)(bsrc + (size_t)(i * 64) * ldb), (GL_LAS unsigned*)(ldsw + 32768 + i * 8192), 16, 0, 0);
  }
}

template <int NI, bool TRANS, bool DEEP = (NI == 2)>
DEV void gemm_kloop(f32x4 (&acc)[NI][8], const bf16_t* __restrict__ Ag, int lda, const bf16_t* __restrict__ Bg, int ldb,
                    int K, unsigned char* smem, bool primed = false) {
  if constexpr (NI == 4) { gemm_kloop_glds64<TRANS>(acc, Ag, lda, Bg, ldb, K, smem, primed); return; }
  bf16_t* sA = (bf16_t*)smem;
  bf16_t* sB = (bf16_t*)(smem + 32768);
  const int tid = otid(), lane = tid & 63, wave = tid >> 6, wm = wave >> 2, wn = wave & 3;
  const int lr = lane & 15, lg = lane >> 4;
  const int crow = tid >> 3, ccol = (tid & 7) * 8;
  const int scol = ((tid & 7) ^ (crow & 7)) * 8;
  const bf16_t* ap = Ag + (size_t)crow * lda + ccol;
  const bf16_t* bp = Bg + (size_t)crow * ldb + ccol;
  const int KT = K >> 6;
  const bf16_t* pa = sA + (wm * 128 + lr) * 64;
  const bf16_t* pb = sB + (wn * NI * 16 + lr) * 64;
#define G_LOAD(RA, RB, K0)                                                                                 \
  {                                                                                                       \
    _Pragma("unroll") for (int i = 0; i < 4; ++i) RA[i] = *(const u32x4*)(ap + (size_t)(64 * i) * lda + (K0)); \
    _Pragma("unroll") for (int i = 0; i < NI; ++i) RB[i] = *(const u32x4*)(bp + (size_t)(64 * i) * ldb + (K0)); \
  }
#define G_STORE(RA, RB, BUF)                                                                               \
  {                                                                                                       \
    _Pragma("unroll") for (int i = 0; i < 4; ++i) *(u32x4*)(sA + (BUF) * 32768 + (crow + 64 * i) * 64 + scol) = RA[i]; \
    _Pragma("unroll") for (int i = 0; i < NI; ++i) *(u32x4*)(sB + (BUF) * 32768 + (crow + 64 * i) * 64 + scol) = RB[i]; \
  }
  if constexpr (DEEP) {
    u32x4 ra0[4], rb0[NI], ra1[4], rb1[NI];
    G_LOAD(ra0, rb0, 0);
    G_LOAD(ra1, rb1, 64);
    G_STORE(ra0, rb0, 0);
    __syncthreads();
    for (int kt = 0; kt < KT; kt += 2) {
      if (kt + 2 < KT) G_LOAD(ra0, rb0, (kt + 2) << 6);
      gemm_compute<NI, TRANS>(acc, pa, pb, lr, lg);
      G_STORE(ra1, rb1, 1);
      __syncthreads();
      if (kt + 3 < KT) G_LOAD(ra1, rb1, (kt + 3) << 6);
      gemm_compute<NI, TRANS>(acc, pa + 32768, pb + 32768, lr, lg);
      if (kt + 2 < KT) G_STORE(ra0, rb0, 0);
      __syncthreads();
    }
  } else {
    u32x4 ra[4], rb[NI];
    G_LOAD(ra, rb, 0);
    G_STORE(ra, rb, 0);
    __syncthreads();
    for (int kt = 0; kt < KT; ++kt) {
      const int buf = kt & 1;
      if (kt + 1 < KT) G_LOAD(ra, rb, (kt + 1) << 6);
      gemm_compute<NI, TRANS>(acc, pa + buf * 32768, pb + buf * 32768, lr, lg);
      if (kt + 1 < KT) G_STORE(ra, rb, buf ^ 1);
      __syncthreads();
    }
  }
#undef G_LOAD
#undef G_STORE
}

DEV bool tile_map(int w, int ntm, int ntn_pad, int sm, int sn, int& tm, int& tn) {
  const int per = sm * sn;
  const int x = w & 7, j = w >> 3;
  const int nsn = ntn_pad / sn;
  const int nsup = (ntm / sm) * nsn;
  const int lo = (x * nsup) >> 3, hi = ((x + 1) * nsup) >> 3;
  const int sup = lo + j / per, within = j % per;
  if (sup >= hi) return false;
  tm = (sup / nsn) * sm + within / sn;
  tn = (sup % nsn) * sn + within % sn;
  return true;
}
DEV int tile_slots(int ntm, int ntn_pad, int sm, int sn) {
  const int nsup = (ntm / sm) * (ntn_pad / sn);
  return ((nsup + 7) / 8) * 8 * sm * sn;
}
DEV int next_slot(int t, int nslots, int ntm, int ntn_pad, int sm, int sn, int& tm, int& tn) {
  while (t < nslots && !tile_map(t, ntm, ntn_pad, sm, sn, tm, tn)) t += gridDim.x;
  return t < nslots ? t : nslots;
}

template <int NI>
DEV void zero_acc(f32x4 (&acc)[NI][8]) {
#pragma unroll
  for (int ni = 0; ni < NI; ++ni)
#pragma unroll
    for (int mi = 0; mi < 8; ++mi) acc[ni][mi] = f32x4{0.f, 0.f, 0.f, 0.f};
}

template <int NI>
DEV void epi_resid(const Params& p, f32x4 (&acc)[NI][8], int m0, int n0, int layer, int slot, float coef) {
  const int tid_ = otid(); const int lane = tid_ & 63, wave = tid_ >> 6, wm = wave >> 2, wn = wave & 3, lr = lane & 15, lg = lane >> 4;
  const float* modv = (const float*)(p.ws + OFF_MOD) + (size_t)layer * 9 * 9216 + slot * 1024;
#pragma unroll
  for (int mi = 0; mi < 8; ++mi) {
    const int m = m0 + wm * 128 + mi * 16 + lr;
    float* xr = xrow_ptr(p, m);
    const float* mv = modv + (size_t)mod_bp(m) * 9216;
#pragma unroll
    for (int ni = 0; ni < NI; ++ni) {
      const int n = n0 + wn * NI * 16 + ni * 16 + lg * 4;
      float4 xv = *(float4*)(xr + n);
      const float4 g = *(const float4*)(mv + n);
      xv.x += coef * g.x * acc[ni][mi][0];
      xv.y += coef * g.y * acc[ni][mi][1];
      xv.z += coef * g.z * acc[ni][mi][2];
      xv.w += coef * g.w * acc[ni][mi][3];
      *(float4*)(xr + n) = xv;
    }
  }
}

DEV int srccol_map(int mt, int n) {
  if (mt == 0) return n;
  if (mt == 1) { const int qd = n >> 5, r = n & 31; return r < 16 ? 16 * qd + r : FF + 16 * qd + (r - 16); }
  if (mt == 2) return n < 2560 ? n : (n < 3712 ? n + 32 : (n < 3744 ? n - 1152 : (n < 3840 ? -1 : (n < 3968 ? n - 96 : -1))));
  return 3872 + n;
}

DEV void convert_tile(const float* __restrict__ src, int ld, int K, int mt, bf16_t* __restrict__ dst, int tile, unsigned char* smem) {
  const int tid = otid() & 255;
  float* t = (float*)(smem + (otid() >> 8) * 16640);
  const int KT = K >> 6;
  const int kt = tile % KT, nt = tile / KT;
  {
    const int j = tid & 63, i0 = tid >> 6;
    const int sc = srccol_map(mt, nt * 64 + j);
#pragma unroll
    for (int ii = 0; ii < 16; ++ii) {
      const int i = i0 + 4 * ii;
      t[i * 65 + j] = sc >= 0 ? src[(size_t)(kt * 64 + i) * ld + sc] : 0.f;
    }
  }
  __syncthreads();
  {
    const int i = (tid & 7) * 8, j0 = tid >> 3;
#pragma unroll
    for (int jj = 0; jj < 2; ++jj) {
      const int j = j0 + 32 * jj;
      uint4 v;
      v.x = pack2(t[(i + 0) * 65 + j], t[(i + 1) * 65 + j]);
      v.y = pack2(t[(i + 2) * 65 + j], t[(i + 3) * 65 + j]);
      v.z = pack2(t[(i + 4) * 65 + j], t[(i + 5) * 65 + j]);
      v.w = pack2(t[(i + 6) * 65 + j], t[(i + 7) * 65 + j]);
      *(uint4*)(dst + (size_t)(nt * 64 + j) * K + kt * 64 + i) = v;
    }
  }
  __syncthreads();
}

constexpr int CONV_TILES = 6656;
DEV void convert_item(const Params& p, int layer, int t, unsigned char* smem) {
  bf16_t* W = (bf16_t*)(p.ws + OFF_W);
  if (t < 1408) { convert_tile(p.w_ffn1_in + (size_t)layer * D * 2 * FF, 2 * FF, D, 1, W + W_UP1, t, smem); return; }
  t -= 1408;
  if (t < 704) { convert_tile(p.w_ffn1_out + (size_t)layer * FF * D, D, FF, 0, W + W_DN1, t, smem); return; }
  t -= 704;
  if (t < 1408) { convert_tile(p.w_ffn2_in + (size_t)layer * D * 2 * FF, 2 * FF, D, 1, W + W_UP2, t, smem); return; }
  t -= 1408;
  if (t < 704) { convert_tile(p.w_ffn2_out + (size_t)layer * FF * D, D, FF, 0, W + W_DN2, t, smem); return; }
  t -= 704;
  if (t < 1024) { convert_tile(p.w_mix_in + (size_t)layer * D * 6944, 6944, D, 2, W + W_MIX, t, smem); return; }
  t -= 1024;
  if (t < 768) { convert_tile(p.w_mix_in + (size_t)layer * D * 6944, 6944, D, 3, W + W_G, t, smem); return; }
  t -= 768;
  if (t < 128) { convert_tile(p.w_br_a + (size_t)layer * 512 * D, D, 512, 0, W + W_BRA, t, smem); return; }
  t -= 128;
  if (t < 128) { convert_tile(p.w_br_b + (size_t)layer * 512 * D, D, 512, 0, W + W_BRB, t, smem); return; }
  t -= 128;
  if (t < 128) { convert_tile(p.w_br_c + (size_t)layer * 512 * D, D, 512, 0, W + W_BRC, t, smem); return; }
  t -= 128;
  convert_tile(p.w_mix_out + (size_t)layer * D * D, D, D, 0, W + W_OUT, t, smem);
}

DEV void mod_item(const Params& p, int item, unsigned char* smem) {
  float* sc = (float*)smem;
  const int tid = otid();
  const int kp = item & 3, lj = item >> 2;
  const int layer = lj / 18, jb = lj % 18;
  for (int i = tid; i < 9 * 256; i += NTHR) {
    const int bp = i >> 8, k = kp * 256 + (i & 255);
    const float v = bp < 8 ? p.c[bp * 1024 + k] : p.c_ctx[k];
    sc[i] = siluf_(v);
  }
  __syncthreads();
  const int j = jb * NTHR + tid;
  float acc[9];
#pragma unroll
  for (int b = 0; b < 9; ++b) acc[b] = 0.f;
  const float* w = p.w_ada + ((size_t)layer * D + kp * 256) * 9216 + j;
#pragma unroll 2
  for (int k = 0; k < 256; k += 4) {
    const float w0 = w[(size_t)(k + 0) * 9216], w1 = w[(size_t)(k + 1) * 9216], w2 = w[(size_t)(k + 2) * 9216], w3 = w[(size_t)(k + 3) * 9216];
#pragma unroll
    for (int b = 0; b < 9; ++b) {
      const float4 s4 = *(const float4*)(sc + b * 256 + k);
      acc[b] += s4.x * w0 + s4.y * w1 + s4.z * w2 + s4.w * w3;
    }
  }
  float* modv = (float*)(p.ws + OFF_MOD) + (size_t)layer * 9 * 9216;
  const float bb = kp == 0 ? p.b_ada[layer * 9216 + j] : 0.f;
#pragma unroll
  for (int b = 0; b < 9; ++b) atomicAdd(modv + (size_t)b * 9216 + j, acc[b] + bb);
  __syncthreads();
}

DEV void phase_prologue(const Params& p, unsigned char* smem) {
  const int tid = otid();
  const int nitems = 288 + 1 + 1088;
  for (int it = blockIdx.x; it < nitems; it += gridDim.x) {
    if (it < 288) {
      mod_item(p, it, smem);
    } else if (it == 288) {
      float* rope = (float*)(p.ws + OFF_ROPE);
      for (int i = tid; i < 1024; i += NTHR) {
        const int pos = i >> 4, fi = i & 15;
        const float freq = powf(10000.0f, -(float)fi / 16.0f);
        const float ang = (float)pos * freq;
        rope[i] = cosf(ang);
        rope[1024 + i] = sinf(ang);
      }
      if (tid < DEPTH) {
        const float* lp = p.diff_lambda + tid * 256;
        float s01 = 0.f, s23 = 0.f;
        for (int i = 0; i < 64; ++i) { s01 += lp[i] * lp[64 + i]; s23 += lp[128 + i] * lp[192 + i]; }
        const float lam_init = 0.8f - 0.6f * expf(-0.3f * (float)tid);
        ((float*)(p.ws + OFF_MISC))[tid] = expf(s01) - expf(s23) + lam_init;
        ((int*)(p.ws + OFF_MISC + 64))[tid] = 0;
      }
    } else {
      const int r0 = (it - 289) * 32;
      for (int i = tid; i < 32 * 256; i += NTHR) {
        const int m = r0 + (i >> 8), c4 = (i & 255) * 4;
        const float4 v = m < NLAT ? *(const float4*)(p.x + (size_t)m * D + c4) : *(const float4*)(p.ctx + (size_t)(m - NLAT) * D + c4);
        *(float4*)(xrow_ptr(p, m) + c4) = v;
      }
    }
  }
}

DEV void phase_norm(const Params& p, int layer, int which, bool conv, unsigned char* smem, int nrows) {
  const int tid = otid(), lane = tid & 63, wave = tid >> 6;
  const int nconv = conv ? CONV_TILES / 2 : 0;
  bf16_t* H = (bf16_t*)(p.ws + OFF_H);
  const float* g = p.norm_g + (size_t)(layer * 3 + which) * D;
  for (int it = blockIdx.x; it < nconv; it += gridDim.x) convert_item(p, layer, it * 2 + (tid >> 8), smem);
  {
    const int nw = gridDim.x * 8, rpw = (nrows + nw - 1) / nw;
    const int r0 = (blockIdx.x * 8 + wave) * rpw;
    for (int rr = 0; rr < rpw; ++rr) {
      const int m = r0 + rr;
      if (m >= nrows) break;
      const float* xr = xrow_ptr(p, m);
      const float* mv = (const float*)(p.ws + OFF_MOD) + ((size_t)layer * 9 + mod_bp(m)) * 9216 + (3 * which) * 1024;
      float4 v[4];
      float ss = 0.f;
#pragma unroll
      for (int q = 0; q < 4; ++q) {
        v[q] = *(const float4*)(xr + q * 256 + lane * 4);
        ss += v[q].x * v[q].x + v[q].y * v[q].y + v[q].z * v[q].z + v[q].w * v[q].w;
      }
#pragma unroll
      for (int o = 32; o >= 1; o >>= 1) ss += __shfl_xor(ss, o);
      const float rstd = rsqrtf(ss * (1.f / 1024.f) + 1e-6f);
#pragma unroll
      for (int q = 0; q < 4; ++q) {
        const int cidx = q * 256 + lane * 4;
        const float4 gg = *(const float4*)(g + cidx);
        const float4 sh = *(const float4*)(mv + cidx);
        const float4 sc = *(const float4*)(mv + 1024 + cidx);
        const float a0 = (v[q].x * rstd * gg.x) * (1.f + sc.x) + sh.x;
        const float a1 = (v[q].y * rstd * gg.y) * (1.f + sc.y) + sh.y;
        const float a2 = (v[q].z * rstd * gg.z) * (1.f + sc.z) + sh.z;
        const float a3 = (v[q].w * rstd * gg.w) * (1.f + sc.w) + sh.w;
        uint2 o2; o2.x = pack2(a0, a1); o2.y = pack2(a2, a3);
        *(uint2*)(H + (size_t)m * D + cidx) = o2;
      }
    }
  }
}

DEV void phase_ffn_up(const Params& p, size_t woff, unsigned char* smem, int ntm) {
  const bf16_t* H = (const bf16_t*)(p.ws + OFF_H);
  const bf16_t* W = (const bf16_t*)(p.ws + OFF_W) + woff;
  bf16_t* hid = (bf16_t*)(p.ws + OFF_U);
  const int tid_ = otid(); const int lane = tid_ & 63, wave = tid_ >> 6, wm = wave >> 2, wn = wave & 3, lr = lane & 15, lg = lane >> 4;
  const int nslots = tile_slots(ntm, 22, 8, 2);
  int tm, tn, tm2 = 0, tn2 = 0;
  bool primed = false;
  for (int t = next_slot(blockIdx.x, nslots, ntm, 22, 8, 2, tm, tn); t < nslots;) {
    const int m0 = tm * 256, n0 = tn * 256;
    f32x4 acc[4][8];
    zero_acc<4>(acc);
    gemm_kloop<4, true>(acc, H + (size_t)m0 * D, D, W + (size_t)n0 * D, D, D, smem, primed);
    t = next_slot(t + gridDim.x, nslots, ntm, 22, 8, 2, tm2, tn2);
    primed = t < nslots;
    if (primed) glds64_prime(H + (size_t)tm2 * 256 * D, D, W + (size_t)tn2 * 256 * D, D, smem);
    tm = tm2; tn = tn2;
#pragma unroll
    for (int mi = 0; mi < 8; ++mi) {
      const int m = m0 + wm * 128 + mi * 16 + lr;
#pragma unroll
      for (int q = 0; q < 2; ++q) {
        const int hc = ((n0 + wn * 64) >> 1) + 16 * q + lg * 4;
        float r[4];
#pragma unroll
        for (int i = 0; i < 4; ++i) r[i] = siluf_(acc[2 * q][mi][i]) * acc[2 * q + 1][mi][i];
        uint2 o2; o2.x = pack2(r[0], r[1]); o2.y = pack2(r[2], r[3]);
        *(uint2*)(hid + (size_t)m * FF + hc) = o2;
      }
    }
  }
}

DEV void phase_gemm_resid(const Params& p, const bf16_t* A, int lda, int K, size_t woff, int layer, int slot, float coef, unsigned char* smem, bool tail) {
  const bf16_t* W = (const bf16_t*)(p.ws + OFF_W) + woff;
  const int nslots = tile_slots(128, 4, 8, 4);
  int tm, tn, tm2 = 0, tn2 = 0;
  bool primed = false;
  for (int t = next_slot(blockIdx.x, nslots, 128, 4, 8, 4, tm, tn); t < nslots;) {
    const int m0 = tm * 256, n0 = tn * 256;
    f32x4 acc[4][8];
    zero_acc<4>(acc);
    gemm_kloop<4, true>(acc, A + (size_t)m0 * lda, lda, W + (size_t)n0 * K, K, K, smem, primed);
    t = next_slot(t + gridDim.x, nslots, 128, 4, 8, 4, tm2, tn2);
    primed = t < nslots;
    if (primed) glds64_prime(A + (size_t)tm2 * 256 * lda, lda, W + (size_t)tn2 * 256 * K, K, smem);
    epi_resid<4>(p, acc, m0, n0, layer, slot, coef);
    tm = tm2; tn = tn2;
  }
  if (tail) {
    for (int u = blockIdx.x; u < 128; u += gridDim.x) {
      const int m0 = (128 + (u >> 4)) * 256, n0 = (u & 15) * 64;
      f32x4 acc[1][8];
      zero_acc<1>(acc);
      gemm_kloop<1, true, true>(acc, A + (size_t)m0 * lda, lda, W + (size_t)n0 * K, K, K, smem);
      epi_resid<1>(p, acc, m0, n0, layer, slot, coef);
    }
  }
}

DEV void phase_mix(const Params& p, unsigned char* smem) {
  const bf16_t* H = (const bf16_t*)(p.ws + OFF_H);
  const bf16_t* W = (const bf16_t*)(p.ws + OFF_W) + W_MIX;
  bf16_t* PB = (bf16_t*)(p.ws + OFF_U);
  bf16_t* VtA = (bf16_t*)(p.ws + OFF_VTA);
  bf16_t* VtC = (bf16_t*)(p.ws + OFF_VTC);
  const float* rope = (const float*)(p.ws + OFF_ROPE);
  const int tid_ = otid(); const int lane = tid_ & 63, wave = tid_ >> 6, wm = wave >> 2, wn = wave & 3, lr = lane & 15, lg = lane >> 4;
  const int nslots = tile_slots(136, 16, 8, 4);
  int tm_, tn_, tm2 = 0, tn2 = 0;
  bool primed = false;
#define MIX_ADVANCE()                                                                                       \
  {                                                                                                        \
    t = next_slot(t + gridDim.x, nslots, 136, 16, 8, 4, tm2, tn2);                                         \
    primed = t < nslots;                                                                                   \
    if (primed) glds64_prime(H + (size_t)tm2 * 256 * D, D, W + (size_t)tn2 * 256 * D, D, smem);            \
    tm_ = tm2; tn_ = tn2;                                                                                  \
  }
  for (int t = next_slot(blockIdx.x, nslots, 136, 16, 8, 4, tm_, tn_); t < nslots;) {
    const int tm = tm_, tn = tn_;
    const int m0 = tm * 256, n0 = tn * 256;
    const bool vtile = (tn == 4) || (tn == 5) || (tn == 15);
    f32x4 acc[4][8];
    zero_acc<4>(acc);
    if (vtile) {
      gemm_kloop<4, false>(acc, H + (size_t)m0 * D, D, W + (size_t)n0 * D, D, D, smem, primed);
      MIX_ADVANCE();
      if (tn == 15 && wn >= 2) continue;
#pragma unroll
      for (int mi = 0; mi < 8; ++mi) {
        const int m = m0 + wm * 128 + mi * 16 + lg * 4;
        int b, pos;
        if (m < NLAT) { b = m >> 12; pos = m & 4095; } else { const int mc = m - NLAT; b = mc >> 8; pos = 4096 + (mc & 255); }
#pragma unroll
        for (int ni = 0; ni < 4; ++ni) {
          const int n = n0 + wn * 64 + ni * 16 + lr;
          uint2 o2; o2.x = pack2(acc[ni][mi][0], acc[ni][mi][1]); o2.y = pack2(acc[ni][mi][2], acc[ni][mi][3]);
          if (tn == 15) {
            const int ea = n - 3840, kvh = ea >> 6, e = ea & 63;
            *(uint2*)(VtC + ((size_t)((b * 2 + kvh) * 64 + e)) * KVLEN + pos) = o2;
          } else {
            const int ea = n - 1024, hh = ea >> 7, e = ea & 127;
            *(uint2*)(VtA + ((size_t)((b * 4 + hh) * 128 + e)) * KVLEN + pos) = o2;
          }
        }
      }
    } else {
      gemm_kloop<4, true>(acc, H + (size_t)m0 * D, D, W + (size_t)n0 * D, D, D, smem, primed);
      MIX_ADVANCE();
      const int gcol = tn * 4 + wn;
      if (gcol == 59) continue;
      const bool do_rope = (gcol < 16) || (gcol >= 48 && gcol < 58);
      const float scl = (gcol < 8 || (gcol >= 48 && gcol < 56)) ? 0.125f * 1.44269504089f : 1.f;
      const int delta = gcol < 16 ? 0 : 512;
#pragma unroll
      for (int mi = 0; mi < 8; ++mi) {
        const int m = m0 + wm * 128 + mi * 16 + lr;
        if (do_rope && m < NLAT) {
          int tpos = m & 4095;
          asm volatile("" : "+v"(tpos));
#pragma unroll
          for (int pr = 0; pr < 2; ++pr) {
            const int pp = pr == 0 ? (tpos >> 6) : (tpos & 63);
            const float4 cs = *(const float4*)(rope + pp * 16 + lg * 4);
            const float4 sn = *(const float4*)(rope + 1024 + pp * 16 + lg * 4);
            const float ca[4] = {cs.x, cs.y, cs.z, cs.w}, sa[4] = {sn.x, sn.y, sn.z, sn.w};
#pragma unroll
            for (int i = 0; i < 4; ++i) {
              const float x0 = acc[2 * pr][mi][i], x1 = acc[2 * pr + 1][mi][i];
              acc[2 * pr][mi][i] = x0 * ca[i] - x1 * sa[i];
              acc[2 * pr + 1][mi][i] = x1 * ca[i] + x0 * sa[i];
            }
          }
        }
#pragma unroll
        for (int ni = 0; ni < 4; ++ni) {
          const int n = n0 + wn * 64 + ni * 16 + lg * 4;
          if (gcol == 58 && ni >= 2) continue;
          uint2 o2;
          o2.x = pack2(acc[ni][mi][0] * scl, acc[ni][mi][1] * scl);
          o2.y = pack2(acc[ni][mi][2] * scl, acc[ni][mi][3] * scl);
          if (gcol >= 40 && gcol < 48) *(uint2*)((bf16_t*)(p.ws + OFF_BR) + (size_t)m * 512 + (n - 2560)) = o2;
          else *(uint2*)(PB + (size_t)m * PBW + (n - delta)) = o2;
        }
      }
    }
  }
}

#undef MIX_ADVANCE
DEV void phase_gates(const Params& p, unsigned char* smem, int ntm) {
  const bf16_t* H = (const bf16_t*)(p.ws + OFF_H);
  const bf16_t* W = (const bf16_t*)(p.ws + OFF_W) + W_G;
  bf16_t* G = (bf16_t*)(p.ws + OFF_U);
  const int tid_ = otid(); const int lane = tid_ & 63, wave = tid_ >> 6, wm = wave >> 2, wn = wave & 3, lr = lane & 15, lg = lane >> 4;
  const int nslots = tile_slots(ntm, 12, 8, 4);
  int tm, tn, tm2 = 0, tn2 = 0;
  bool primed = false;
  for (int t = next_slot(blockIdx.x, nslots, ntm, 12, 8, 4, tm, tn); t < nslots;) {
    const int m0 = tm * 256, n0 = tn * 256;
    f32x4 acc[4][8];
    zero_acc<4>(acc);
    gemm_kloop<4, true>(acc, H + (size_t)m0 * D, D, W + (size_t)n0 * D, D, D, smem, primed);
    t = next_slot(t + gridDim.x, nslots, ntm, 12, 8, 4, tm2, tn2);
    primed = t < nslots;
    if (primed) glds64_prime(H + (size_t)tm2 * 256 * D, D, W + (size_t)tn2 * 256 * D, D, smem);
    tm = tm2; tn = tn2;
#pragma unroll
    for (int mi = 0; mi < 8; ++mi) {
      const int m = m0 + wm * 128 + mi * 16 + lr;
#pragma unroll
      for (int ni = 0; ni < 4; ++ni) {
        const int n = n0 + wn * 64 + ni * 16 + lg * 4;
        uint2 o2;
        o2.x = pack2(sigmoidf_(acc[ni][mi][0]), sigmoidf_(acc[ni][mi][1]));
        o2.y = pack2(sigmoidf_(acc[ni][mi][2]), sigmoidf_(acc[ni][mi][3]));
        *(uint2*)(G + (size_t)m * 3072 + n) = o2;
      }
    }
  }
}

DEV void phase_merge(const Params& p, unsigned char* smem, int ntm) {
  const bf16_t* Wb = (const bf16_t*)(p.ws + OFF_W);
  const bf16_t* O = (const bf16_t*)(p.ws + OFF_O);
  const bf16_t* G = (const bf16_t*)(p.ws + OFF_U);
  bf16_t* Y = (bf16_t*)(p.ws + OFF_Y);
  const int tid_ = otid(); const int lane = tid_ & 63, wave = tid_ >> 6, wm = wave >> 2, wn = wave & 3, lr = lane & 15, lg = lane >> 4;
  const int nslots = tile_slots(ntm, 8, 4, 8);
  for (int t = blockIdx.x; t < nslots; t += gridDim.x) {
    int tm, tn;
    if (!tile_map(t, ntm, 8, 4, 8, tm, tn)) continue;
    const int m0 = tm * 256, n0 = tn * 128;
    f32x4 y[2][8];
    zero_acc<2>(y);
#pragma unroll 1
    for (int i = 0; i < 3; ++i) {
      u32x4 gq4[4];
      const bf16_t* gbase = G + (size_t)(m0 + wm * 128 + lr) * 3072 + i * 1024 + n0 + wn * 32 + lg * 4;
#pragma unroll
      for (int mi = 0; mi < 4; ++mi) {
        const uint2 g0 = *(const uint2*)(gbase + (size_t)(mi * 16) * 3072);
        const uint2 g1 = *(const uint2*)(gbase + (size_t)(mi * 16) * 3072 + 16);
        gq4[mi] = u32x4{g0.x, g0.y, g1.x, g1.y};
      }
      f32x4 acc[2][8];
      zero_acc<2>(acc);
      gemm_kloop<2, true, false>(acc, O + (size_t)m0 * 1536 + i * 512, 1536, Wb + W_BRA + (size_t)i * 524288 + (size_t)n0 * 512, 512, 512, smem);
#pragma unroll
      for (int mi = 0; mi < 8; ++mi) {
#pragma unroll
        for (int ni = 0; ni < 2; ++ni) {
          uint2 gq;
          if (mi < 4) { gq.x = gq4[mi][2 * ni]; gq.y = gq4[mi][2 * ni + 1]; }
          else gq = *(const uint2*)(gbase + (size_t)(mi * 16) * 3072 + ni * 16);
          y[ni][mi][0] += __uint_as_float(gq.x << 16) * acc[ni][mi][0];
          y[ni][mi][1] += __uint_as_float(gq.x & 0xffff0000u) * acc[ni][mi][1];
          y[ni][mi][2] += __uint_as_float(gq.y << 16) * acc[ni][mi][2];
          y[ni][mi][3] += __uint_as_float(gq.y & 0xffff0000u) * acc[ni][mi][3];
        }
      }
    }
#pragma unroll
    for (int mi = 0; mi < 8; ++mi) {
      const int m = m0 + wm * 128 + mi * 16 + lr;
#pragma unroll
      for (int ni = 0; ni < 2; ++ni) {
        const int n = n0 + wn * 32 + ni * 16 + lg * 4;
        uint2 o2; o2.x = pack2(y[ni][mi][0], y[ni][mi][1]); o2.y = pack2(y[ni][mi][2], y[ni][mi][3]);
        *(uint2*)(Y + (size_t)m * D + n) = o2;
      }
    }
  }
}

DEV int key_row(int b, int tp) { return tp < 64 ? b * 4096 + tp * 64 : NLAT + b * 256 + (tp - 64) * 64; }

template <int NMAP, int EF>
DEV void flash_item(unsigned char* smem, const bf16_t* __restrict__ PB, int qrow0, int qcol0, int kcol0,
                    const bf16_t* __restrict__ Vt, int b, int ra0, int ra1, int rb0, int rb1, int win_qpos0,
                    float sinkv, bool use_sink, bf16_t* __restrict__ Oout, int ocol0, float lam, float oscale,
                    const float* __restrict__ subln) {
  bf16_t* sK = (bf16_t*)smem;
  bf16_t* sV = (bf16_t*)(smem + 49152);
  const int tid = otid(), lane = tid & 63, wave = tid >> 6, lr = lane & 15, lg = lane >> 4;
  const int na = ra1 - ra0, nt = na + (rb1 - rb0);
  bf16x8 qf[NMAP][2];
  {
    const bf16_t* qp = PB + (size_t)(qrow0 + wave * 16 + lr) * PBW + qcol0 + lg * 8;
#pragma unroll
    for (int mp = 0; mp < NMAP; ++mp)
#pragma unroll
      for (int ks = 0; ks < 2; ++ks) qf[mp][ks] = *(const bf16x8*)(qp + mp * 64 + ks * 32);
  }
  f32x4 Oa[NMAP][EF];
  float mrun[NMAP], lsum[NMAP];
#pragma unroll
  for (int mp = 0; mp < NMAP; ++mp) {
    mrun[mp] = use_sink ? sinkv : -1e30f;
    lsum[mp] = 0.f;
#pragma unroll
    for (int ef = 0; ef < EF; ++ef) Oa[mp][ef] = f32x4{0.f, 0.f, 0.f, 0.f};
  }
  constexpr int NKC = NMAP, NVC = EF / 4;
  u32x4 rk[NKC], rv[NVC];
  const int crow = tid >> 3, ccol = (tid & 7) * 8;
  const int scol = ((tid & 7) ^ (crow & 7)) * 8;
#define FL_GLOAD(TI)                                                                                          \
  {                                                                                                         \
    const int tpn_ = (TI) < na ? ra0 + (TI) : rb0 + ((TI) - na);                                            \
    const bf16_t* kp_ = PB + (size_t)(key_row(b, tpn_) + crow) * PBW + kcol0 + ccol;                        \
    _Pragma("unroll") for (int mp = 0; mp < NMAP; ++mp)                                                     \
      rk[mp] = *(const u32x4*)(kp_ + mp * 64);                                                              \
    const bf16_t* vp_ = Vt + (size_t)crow * KVLEN + tpn_ * 64 + ccol;                                       \
    _Pragma("unroll") for (int i = 0; i < NVC; ++i) rv[i] = *(const u32x4*)(vp_ + (size_t)(64 * i) * KVLEN); \
  }
#define FL_SSTORE(BUF)                                                                                      \
  {                                                                                                         \
    _Pragma("unroll") for (int mp = 0; mp < NMAP; ++mp)                                                     \
      *(u32x4*)(sK + (((BUF) * 2 + mp) * 64 + crow) * 64 + scol) = rk[mp];                                  \
    _Pragma("unroll") for (int i = 0; i < NVC; ++i)                                                         \
      *(u32x4*)(sV + ((BUF) * 128 + crow + 64 * i) * 72 + ccol) = rv[i];                                    \
  }
  FL_GLOAD(0);
  FL_SSTORE(0);
  __syncthreads();
  bf16x8 pk[NMAP][2];
#pragma unroll
  for (int mp = 0; mp < NMAP; ++mp) { pk[mp][0] = bf16x8{0, 0, 0, 0, 0, 0, 0, 0}; pk[mp][1] = bf16x8{0, 0, 0, 0, 0, 0, 0, 0}; }
#define FL_PV(VBUF)                                                                                          \
  {                                                                                                         \
    _Pragma("unroll") for (int ef = 0; ef < EF; ++ef)                                                       \
      _Pragma("unroll") for (int s2 = 0; s2 < 2; ++s2) {                                                    \
        const bf16_t* vp = sV + ((VBUF) * 128 + ef * 16 + lr) * 72 + s2 * 32 + lg * 4;                      \
        const uint2 v0 = *(const uint2*)vp;                                                                 \
        const uint2 v1 = *(const uint2*)(vp + 16);                                                          \
        const u32x4 cvu = {v0.x, v0.y, v1.x, v1.y};                                                         \
        const bf16x8 cvh = __builtin_bit_cast(bf16x8, cvu);                                                 \
        _Pragma("unroll") for (int mp = 0; mp < NMAP; ++mp) Oa[mp][ef] = mfma16(cvh, pk[mp][s2], Oa[mp][ef]); \
      }                                                                                                     \
  }
  int buf = 0, pbuf = 0;
  for (int ti = 0; ti < nt; ++ti) {
    const int tp = ti < na ? ra0 + ti : rb0 + (ti - na);
    const int nbuf = buf == 2 ? 0 : buf + 1;
    if (ti + 1 < nt) FL_GLOAD(ti + 1);
    f32x4 s[NMAP][4];
#pragma unroll
    for (int mp = 0; mp < NMAP; ++mp)
#pragma unroll
      for (int kf = 0; kf < 4; ++kf) {
        s[mp][kf] = f32x4{0.f, 0.f, 0.f, 0.f};
#pragma unroll
        for (int ks = 0; ks < 2; ++ks) {
          const bf16x8 kfr = *(const bf16x8*)(sK + ((buf * 2 + mp) * 64 + kf * 16 + lr) * 64 + (((ks * 4 + lg) ^ (lr & 7)) * 8));
          s[mp][kf] = mfma16(kfr, qf[mp][ks], s[mp][kf]);
        }
      }
    FL_PV(pbuf);
    bf16x8 pkn[NMAP][2];
    float alpha[NMAP];
#pragma unroll
    for (int mp = 0; mp < NMAP; ++mp) {
      if (win_qpos0 >= 0 && tp < 64) {
        const int qpos = win_qpos0 + wave * 16 + lr;
#pragma unroll
        for (int kf = 0; kf < 4; ++kf)
#pragma unroll
          for (int r = 0; r < 4; ++r) {
            const int dd = tp * 64 + kf * 16 + lg * 4 + r - qpos;
            if (dd > 128 || dd < -128) s[mp][kf][r] = -1e30f;
          }
      }
      float mx = -1e30f;
#pragma unroll
      for (int kf = 0; kf < 4; ++kf)
#pragma unroll
        for (int r = 0; r < 4; ++r) mx = fmaxf(mx, s[mp][kf][r]);
      mx = fmaxf(mx, __shfl_xor(mx, 16));
      mx = fmaxf(mx, __shfl_xor(mx, 32));
      const float mnew = fmaxf(mrun[mp], mx);
      alpha[mp] = __builtin_amdgcn_exp2f(mrun[mp] - mnew);
      mrun[mp] = mnew;
      float ps = 0.f;
#pragma unroll
      for (int kf = 0; kf < 4; ++kf)
#pragma unroll
        for (int r = 0; r < 4; ++r) {
          const float pv = __builtin_amdgcn_exp2f(s[mp][kf][r] - mnew);
          s[mp][kf][r] = pv;
          ps += pv;
        }
      lsum[mp] = lsum[mp] * alpha[mp] + ps;
#pragma unroll
      for (int s2 = 0; s2 < 2; ++s2) {
        bf16x8 t;
#pragma unroll
        for (int r = 0; r < 4; ++r) {
          t[r] = (short)f2bf(s[mp][2 * s2][r]);
          t[4 + r] = (short)f2bf(s[mp][2 * s2 + 1][r]);
        }
        pkn[mp][s2] = t;
      }
    }
#pragma unroll
    for (int mp = 0; mp < NMAP; ++mp) {
#pragma unroll
      for (int ef = 0; ef < EF; ++ef) {
        Oa[mp][ef][0] *= alpha[mp]; Oa[mp][ef][1] *= alpha[mp]; Oa[mp][ef][2] *= alpha[mp]; Oa[mp][ef][3] *= alpha[mp];
      }
#pragma unroll
      for (int s2 = 0; s2 < 2; ++s2) pk[mp][s2] = pkn[mp][s2];
    }
    if (ti + 1 < nt) FL_SSTORE(nbuf);
    __syncthreads();
    pbuf = buf;
    buf = nbuf;
  }
  FL_PV(pbuf);
  __syncthreads();
#undef FL_PV
  float inv[NMAP];
#pragma unroll
  for (int mp = 0; mp < NMAP; ++mp) {
    float lt = lsum[mp];
    lt += __shfl_xor(lt, 16);
    lt += __shfl_xor(lt, 32);
    if (use_sink) lt += __builtin_amdgcn_exp2f(sinkv - mrun[mp]);
    inv[mp] = 1.f / lt;
  }
  bf16_t* op = Oout + (size_t)(qrow0 + wave * 16 + lr) * 1536 + ocol0 + lg * 4;
  if constexpr (NMAP == 2) {
    const float i0 = inv[0], i1 = lam * inv[1];
    float ss = 0.f;
#pragma unroll
    for (int ef = 0; ef < EF; ++ef)
#pragma unroll
      for (int r = 0; r < 4; ++r) {
        const float o = Oa[0][ef][r] * i0 - Oa[1][ef][r] * i1;
        Oa[0][ef][r] = o;
        ss += o * o;
      }
    ss += __shfl_xor(ss, 16);
    ss += __shfl_xor(ss, 32);
    const float rstd = rsqrtf(ss * (1.f / 128.f) + 1e-6f) * oscale;
#pragma unroll
    for (int ef = 0; ef < EF; ++ef) {
      const float4 g = *(const float4*)(subln + ef * 16 + lg * 4);
      uint2 o2;
      o2.x = pack2(Oa[0][ef][0] * rstd * g.x, Oa[0][ef][1] * rstd * g.y);
      o2.y = pack2(Oa[0][ef][2] * rstd * g.z, Oa[0][ef][3] * rstd * g.w);
      *(uint2*)(op + ef * 16) = o2;
    }
  } else {
#pragma unroll
    for (int ef = 0; ef < EF; ++ef) {
      uint2 o2;
      o2.x = pack2(Oa[0][ef][0] * inv[0], Oa[0][ef][1] * inv[0]);
      o2.y = pack2(Oa[0][ef][2] * inv[0], Oa[0][ef][3] * inv[0]);
      *(uint2*)(op + ef * 16) = o2;
    }
  }
}

DEV void gla_item(const Params& p, int layer, int b, int h, int dir, unsigned char* smem) {
  bf16_t* sQe = (bf16_t*)smem;
  bf16_t* sKe = (bf16_t*)(smem + 9216);
  bf16_t* sKdT = (bf16_t*)(smem + 18432);
  bf16_t* sVT = (bf16_t*)(smem + 27648);
  bf16_t* sST = (bf16_t*)(smem + 46080);
  float* sLR = (float*)(smem + 64512);
  float* sTot = (float*)(smem + 68608);
  float* sDec = (float*)(smem + 70656);
  const bf16_t* PB = (const bf16_t*)(p.ws + OFF_U);
  bf16_t* OFB = (bf16_t*)(p.ws + OFF_OFB) + (size_t)dir * MROWS * 512;
  const int tid = otid(), lane = tid & 63, wave = tid >> 6, lr = lane & 15, lg = lane >> 4;
  const int cch = tid & 63, qd = tid >> 6;
  float gwr[16];
#pragma unroll
  for (int r = 0; r < 16; ++r) gwr[r] = p.gla_gate_w[(size_t)((layer * 2 + dir) * 16 + r) * 256 + h * 64 + cch];
  const float gbv = p.gla_gate_b[(layer * 2 + dir) * 256 + h * 64 + cch];
  f32x4 st[4];
#pragma unroll
  for (int c = 0; c < 4; ++c) st[c] = f32x4{0.f, 0.f, 0.f, 0.f};
  for (int i = tid; i < 18432 / 4; i += NTHR) ((unsigned*)sST)[i] = 0u;
  __syncthreads();
  uint2 lrv;
  unsigned qraw[8], kraw[8], vraw[16];
#define GLA_PREFETCH(STEP)                                                                                  \
  {                                                                                                        \
    const int tpn_ = dir == 0 ? ((STEP) < 4 ? 64 + (STEP) : (STEP) - 4) : 67 - (STEP);                      \
    const int rb_ = key_row(b, tpn_);                                                                      \
    if (tid < 256) lrv = *(const uint2*)(PB + (size_t)(rb_ + (tid >> 2)) * PBW + PB_LR + dir * 16 + (tid & 3) * 4); \
    const bf16_t* qp_ = PB + (size_t)(rb_ + qd * 8) * PBW + PB_BQ + h * 64 + cch;                          \
    const bf16_t* kp_ = PB + (size_t)(rb_ + qd * 8) * PBW + PB_BK + h * 64 + cch;                          \
    _Pragma("unroll") for (int pi = 0; pi < 8; ++pi) { qraw[pi] = qp_[(size_t)pi * PBW]; kraw[pi] = kp_[(size_t)pi * PBW]; } \
    const bf16_t* vp_ = PB + (size_t)(rb_ + (tid >> 7) * 16) * PBW + PB_BV + h * 128 + (tid & 127);        \
    _Pragma("unroll") for (int j = 0; j < 16; ++j) vraw[j] = vp_[(size_t)j * PBW];                         \
  }
  GLA_PREFETCH(0);
  for (int step = 0; step < 68; ++step) {
    const int tp = dir == 0 ? (step < 4 ? 64 + step : step - 4) : 67 - step;
    const int rowbase = key_row(b, tp);
    {
      if (tid < 256) {
        const int pp = tid >> 2, r4 = (tid & 3) * 4;
        sLR[pp * 16 + r4 + 0] = bf2f((unsigned short)(lrv.x & 0xffff));
        sLR[pp * 16 + r4 + 1] = bf2f((unsigned short)(lrv.x >> 16));
        sLR[pp * 16 + r4 + 2] = bf2f((unsigned short)(lrv.y & 0xffff));
        sLR[pp * 16 + r4 + 3] = bf2f((unsigned short)(lrv.y >> 16));
      }
      const int e = tid & 127, ph = tid >> 7;
#pragma unroll
      for (int k8 = 0; k8 < 2; ++k8) {
        uint4 o4;
        o4.x = (unsigned)vraw[k8 * 8 + 0] | ((unsigned)vraw[k8 * 8 + 1] << 16);
        o4.y = (unsigned)vraw[k8 * 8 + 2] | ((unsigned)vraw[k8 * 8 + 3] << 16);
        o4.z = (unsigned)vraw[k8 * 8 + 4] | ((unsigned)vraw[k8 * 8 + 5] << 16);
        o4.w = (unsigned)vraw[k8 * 8 + 6] | ((unsigned)vraw[k8 * 8 + 7] << 16);
        *(uint4*)(sVT + e * 72 + ph * 16 + k8 * 8) = o4;
      }
    }
    __syncthreads();
    float cum[8];
    {
      float run = 0.f;
      if (dir == 0) {
#pragma unroll
        for (int pi = 0; pi < 8; ++pi) {
          const float* lrp = sLR + (qd * 8 + pi) * 16;
          float z = gbv;
#pragma unroll
          for (int r = 0; r < 16; ++r) z += lrp[r] * gwr[r];
          const float la = (fminf(z, 0.f) - __logf(1.f + __expf(-fabsf(z)))) * (1.f / 16.f);
          run += la;
          cum[pi] = run;
        }
      } else {
#pragma unroll
        for (int pi = 7; pi >= 0; --pi) {
          const float* lrp = sLR + (qd * 8 + pi) * 16;
          float z = gbv;
#pragma unroll
          for (int r = 0; r < 16; ++r) z += lrp[r] * gwr[r];
          const float la = (fminf(z, 0.f) - __logf(1.f + __expf(-fabsf(z)))) * (1.f / 16.f);
          run += la;
          cum[pi] = run;
        }
      }
      sTot[qd * 64 + cch] = run;
    }
    __syncthreads();
    {
      float last = 0.f, off = 0.f;
#pragma unroll
      for (int q8 = 0; q8 < 8; ++q8) {
        const float tq = sTot[q8 * 64 + cch];
        last += tq;
        if (dir == 0 ? (q8 < qd) : (q8 > qd)) off += tq;
      }
      if (qd == 0) sDec[cch] = __expf(last);
      unsigned short kdp[8];
#pragma unroll
      for (int pi = 0; pi < 8; ++pi) {
        const float cm = cum[pi] + off;
        const float qv = __uint_as_float(qraw[pi] << 16);
        const float kv = __uint_as_float(kraw[pi] << 16);
        sQe[(qd * 8 + pi) * 72 + cch] = f2bf(qv * 0.125f * __expf(cm));
        sKe[(qd * 8 + pi) * 72 + cch] = f2bf(kv * __expf(-cm));
        kdp[pi] = f2bf(kv * __expf(last - cm));
      }
      uint4 o4;
      o4.x = (unsigned)kdp[0] | ((unsigned)kdp[1] << 16);
      o4.y = (unsigned)kdp[2] | ((unsigned)kdp[3] << 16);
      o4.z = (unsigned)kdp[4] | ((unsigned)kdp[5] << 16);
      o4.w = (unsigned)kdp[6] | ((unsigned)kdp[7] << 16);
      *(uint4*)(sKdT + cch * 72 + qd * 8) = o4;
    }
    if (step + 1 < 68) GLA_PREFETCH(step + 1);
    __syncthreads();
#pragma unroll
    for (int iq = 0; iq < 4; ++iq) {
      bf16x8 qfr[2];
#pragma unroll
      for (int ks = 0; ks < 2; ++ks) qfr[ks] = *(const bf16x8*)(sQe + (iq * 16 + lr) * 72 + ks * 32 + lg * 8);
      bf16x8 ap[2];
      bool live[2];
#pragma unroll
      for (int s2 = 0; s2 < 2; ++s2) {
        f32x4 at[2];
        live[s2] = dir == 0 ? (2 * s2 <= iq) : (2 * s2 + 1 >= iq);
#pragma unroll
        for (int jj = 0; jj < 2; ++jj) {
          const int jf = 2 * s2 + jj;
          at[jj] = f32x4{0.f, 0.f, 0.f, 0.f};
          const bool tile_live = dir == 0 ? (jf <= iq) : (jf >= iq);
          if (tile_live) {
#pragma unroll
            for (int ks = 0; ks < 2; ++ks) {
              const bf16x8 kfr = *(const bf16x8*)(sKe + (jf * 16 + lr) * 72 + ks * 32 + lg * 8);
              at[jj] = mfma16(kfr, qfr[ks], at[jj]);
            }
            if (jf == iq) {
              const int ipos = lr;
#pragma unroll
              for (int r = 0; r < 4; ++r) {
                const int jpos = lg * 4 + r;
                const bool keep = dir == 0 ? (ipos >= jpos) : (ipos <= jpos);
                if (!keep) at[jj][r] = 0.f;
              }
            }
          }
        }
        bf16x8 t;
#pragma unroll
        for (int r = 0; r < 4; ++r) { t[r] = (short)f2bf(at[0][r]); t[4 + r] = (short)f2bf(at[1][r]); }
        ap[s2] = t;
      }
      {
        const int erow = wave * 16 + lr;
        f32x4 o = f32x4{0.f, 0.f, 0.f, 0.f};
#pragma unroll
        for (int s2 = 0; s2 < 2; ++s2) {
          if (live[s2]) {
            const bf16_t* vp = sVT + erow * 72 + s2 * 32 + lg * 4;
            const uint2 v0 = *(const uint2*)vp;
            const uint2 v1 = *(const uint2*)(vp + 16);
            const u32x4 cvu = {v0.x, v0.y, v1.x, v1.y};
            o = mfma16(__builtin_bit_cast(bf16x8, cvu), ap[s2], o);
          }
        }
#pragma unroll
        for (int ks = 0; ks < 2; ++ks) {
          const bf16x8 sfr = *(const bf16x8*)(sST + erow * 72 + ks * 32 + lg * 8);
          o = mfma16(sfr, qfr[ks], o);
        }
        uint2 o2; o2.x = pack2(o[0], o[1]); o2.y = pack2(o[2], o[3]);
        *(uint2*)(OFB + (size_t)(rowbase + iq * 16 + lr) * 512 + h * 128 + wave * 16 + lg * 4) = o2;
      }
    }
    {
      const int erow = wave * 16 + lr;
      bf16x8 vfr[2];
#pragma unroll
      for (int ps = 0; ps < 2; ++ps) vfr[ps] = *(const bf16x8*)(sVT + erow * 72 + ps * 32 + lg * 8);
#pragma unroll
      for (int cf = 0; cf < 4; ++cf) {
        const float dc = sDec[cf * 16 + lr];
        f32x4 a = st[cf];
        a[0] *= dc; a[1] *= dc; a[2] *= dc; a[3] *= dc;
#pragma unroll
        for (int ps = 0; ps < 2; ++ps) {
          const bf16x8 kdf = *(const bf16x8*)(sKdT + (cf * 16 + lr) * 72 + ps * 32 + lg * 8);
          a = mfma16(vfr[ps], kdf, a);
        }
        st[cf] = a;
      }
    }
#pragma unroll
    for (int cf = 0; cf < 4; ++cf)
#pragma unroll
      for (int r = 0; r < 4; ++r)
        sST[(wave * 16 + lg * 4 + r) * 72 + cf * 16 + lr] = f2bf(st[cf][r]);
    __syncthreads();
  }
}

#undef GLA_PREFETCH

DEV void phase_mixers(const Params& p, int layer, unsigned char* smem) {
  volatile int* s_itemp = (volatile int*)(smem + LDS_MISC);
  const bf16_t* PB = (const bf16_t*)(p.ws + OFF_U);
  const bf16_t* VtA = (const bf16_t*)(p.ws + OFF_VTA);
  const bf16_t* VtC = (const bf16_t*)(p.ws + OFF_VTC);
  bf16_t* O = (bf16_t*)(p.ws + OFF_O);
  int* ctr = (int*)(p.ws + OFF_MISC + 64) + layer;
  const float lam = ((const float*)(p.ws + OFF_MISC))[layer];
  const float lam_init = 0.8f - 0.6f * expf(-0.3f * (float)layer);
  const int total = 64 + 1024 + 64 + 2048 + 128;
  for (;;) {
    if (otid() == 0) *s_itemp = atomicAdd(ctr, 1);
    __syncthreads();
    int idx = __builtin_amdgcn_readfirstlane(*s_itemp);
    __syncthreads();
    if (idx >= total) break;
    if (idx < 64) {
      gla_item(p, layer, idx >> 3, (idx >> 1) & 3, idx & 1, smem);
      continue;
    }
    idx -= 64;
    if (idx < 1024 + 64) {
      int b, h, qrow0, r0;
      if (idx < 1024) { b = idx >> 7; h = (idx >> 5) & 3; qrow0 = b * 4096 + (idx & 31) * 128; r0 = 0; }
      else { const int j = idx - 1024; b = j >> 3; h = (j >> 1) & 3; qrow0 = NLAT + b * 256 + (j & 1) * 128; r0 = 64; }
      flash_item<2, 8>(smem, PB, qrow0, PB_AQ + h * 128, PB_AK + h * 128, VtA + (size_t)((b * 4 + h) * 128) * KVLEN, b,
                       r0, 68, 0, 0, -1, 0.f, false, O, h * 128, lam, 1.f - lam_init, p.diff_subln + layer * 128);
      continue;
    }
    idx -= 1024 + 64;
    {
      int b, hq, qrow0, lo, hi, r0, r1, win;
      if (idx < 2048) {
        b = idx >> 8; hq = (idx >> 5) & 7; const int qt = idx & 31;
        qrow0 = b * 4096 + qt * 128; lo = 2 * qt - 2 < 0 ? 0 : 2 * qt - 2; hi = 2 * qt + 4 > 64 ? 64 : 2 * qt + 4; r0 = 64; r1 = 68; win = qt * 128;
      } else {
        const int j = idx - 2048; b = j >> 4; hq = (j >> 1) & 7;
        qrow0 = NLAT + b * 256 + (j & 1) * 128; lo = 64; hi = 68; r0 = 0; r1 = 0; win = -1;
      }
      const int kvh = hq >> 2;
      flash_item<1, 4>(smem, PB, qrow0, PB_CQ + hq * 64, PB_CK + kvh * 64, VtC + (size_t)((b * 2 + kvh) * 64) * KVLEN, b,
                       lo, hi, r0, r1, win, p.swa_sink[layer * 8 + hq] * 1.44269504089f, true, O, 1024 + hq * 64, 0.f, 1.f, nullptr);
    }
  }
}

DEV void phase_gla_final(const Params& p, int layer) {
  const int tid = otid(), lane = tid & 63, wave = tid >> 6;
  const bf16_t* PB = (const bf16_t*)(p.ws + OFF_U);
  const bf16_t* OF = (const bf16_t*)(p.ws + OFF_OFB);
  const bf16_t* OB = OF + (size_t)MROWS * 512;
  bf16_t* O = (bf16_t*)(p.ws + OFF_O);
  const float* gn = p.gla_norm + layer * 128;
  const int nitems = MROWS / 32;
  for (int it = blockIdx.x; it < nitems; it += gridDim.x) {
    for (int rr = 0; rr < 4; ++rr) {
      const int m = it * 32 + wave * 4 + rr;
      const uint4 a = *(const uint4*)(OF + (size_t)m * 512 + lane * 8);
      const uint4 bq = *(const uint4*)(OB + (size_t)m * 512 + lane * 8);
      const uint4 rq = *(const uint4*)((const bf16_t*)(p.ws + OFF_BR) + (size_t)m * 512 + lane * 8);
      const unsigned aw[4] = {a.x, a.y, a.z, a.w}, bw[4] = {bq.x, bq.y, bq.z, bq.w}, rw[4] = {rq.x, rq.y, rq.z, rq.w};
      float o[8], rv[8];
      float ss = 0.f;
#pragma unroll
      for (int i = 0; i < 4; ++i) {
        o[2 * i] = bf2f((unsigned short)(aw[i] & 0xffff)) + bf2f((unsigned short)(bw[i] & 0xffff));
        o[2 * i + 1] = bf2f((unsigned short)(aw[i] >> 16)) + bf2f((unsigned short)(bw[i] >> 16));
        rv[2 * i] = bf2f((unsigned short)(rw[i] & 0xffff));
        rv[2 * i + 1] = bf2f((unsigned short)(rw[i] >> 16));
        ss += o[2 * i] * o[2 * i] + o[2 * i + 1] * o[2 * i + 1];
      }
      ss += __shfl_xor(ss, 1); ss += __shfl_xor(ss, 2); ss += __shfl_xor(ss, 4); ss += __shfl_xor(ss, 8);
      const float rstd = rsqrtf(ss * (1.f / 128.f) + 1e-6f);
      const int e0 = (lane & 15) * 8;
      float res[8];
#pragma unroll
      for (int i = 0; i < 8; ++i) res[i] = o[i] * rstd * gn[e0 + i] * siluf_(rv[i]);
      uint4 o4;
      o4.x = pack2(res[0], res[1]); o4.y = pack2(res[2], res[3]); o4.z = pack2(res[4], res[5]); o4.w = pack2(res[6], res[7]);
      *(uint4*)(O + (size_t)m * 1536 + 512 + lane * 8) = o4;
    }
  }
}

DEV void phase_final(const Params& p) {
  const int tid = otid(), lane = tid & 63, wave = tid >> 6;
  const int nitems = NLAT / 32;
  for (int it = blockIdx.x; it < nitems; it += gridDim.x) {
    for (int rr = 0; rr < 4; ++rr) {
      const int m = it * 32 + wave * 4 + rr;
      float* xr = p.out + (size_t)m * D;
      float4 v[4];
      float ss = 0.f;
#pragma unroll
      for (int q = 0; q < 4; ++q) {
        v[q] = *(const float4*)(xr + q * 256 + lane * 4);
        ss += v[q].x * v[q].x + v[q].y * v[q].y + v[q].z * v[q].z + v[q].w * v[q].w;
      }
#pragma unroll
      for (int o = 32; o >= 1; o >>= 1) ss += __shfl_xor(ss, o);
      const float rstd = rsqrtf(ss * (1.f / 1024.f) + 1e-6f);
#pragma unroll
      for (int q = 0; q < 4; ++q) {
        const float4 g = *(const float4*)(p.final_g + q * 256 + lane * 4);
        float4 o4;
        o4.x = v[q].x * rstd * g.x; o4.y = v[q].y * rstd * g.y; o4.z = v[q].z * rstd * g.z; o4.w = v[q].w * rstd * g.w;
        *(float4*)(xr + q * 256 + lane * 4) = o4;
      }
    }
  }
}


#define XB_TMO      128
#define XB_XCNT(j)  (256  + 64 * (j))
#define XB_XSUB(j)  (1280 + 64 * (j))
#define XB_XGEN(j)  (2304 + 64 * (j))
#define XB_TOP      3328
#define XB_TOPGEN   3392
#define XCD_BAR_WORDS 3456
#define XB_SPIN_CAP (1u << 22)
#define LAS __attribute__((address_space(3)))
DEV unsigned xb_ld(unsigned* p) { return __hip_atomic_load(p, __ATOMIC_RELAXED, __HIP_MEMORY_SCOPE_AGENT); }
DEV unsigned xb_add(unsigned* p, unsigned v) { return __hip_atomic_fetch_add(p, v, __ATOMIC_RELAXED, __HIP_MEMORY_SCOPE_AGENT); }
DEV unsigned xb_xcc_id() { return (unsigned)__builtin_amdgcn_s_getreg((3 << 11) | 20) & 0xFu; }
#define XB_SPIN(cond, bar) do { unsigned _sp = 0; while (cond) { __builtin_amdgcn_s_sleep(1); \
    if ((++_sp & 255u) == 0u) { if (xb_ld(&(bar)[XB_TMO])) break; if (_sp > XB_SPIN_CAP) { atomicAdd(&(bar)[XB_TMO], 1u); break; } } } } while (0)
struct XcdBarrier { unsigned* bar; unsigned x; volatile LAS unsigned* st; };
DEV XcdBarrier xcd_barrier_post(unsigned* bar, volatile LAS unsigned* st) {
  XcdBarrier b; b.bar = bar; b.x = xb_xcc_id(); b.st = st;
  if (threadIdx.x == 0) (void)xb_add(&bar[XB_XCNT(b.x)], 1u);
  return b;
}
DEV void xcd_barrier_complete(unsigned* bar, unsigned x, unsigned& nloc, unsigned& nx) {
  const unsigned G = gridDim.x * gridDim.y * gridDim.z;
  unsigned sum, cnt, mine, sp = 0u;
  for (;;) {
    sum = 0u; cnt = 0u; mine = 0u;
#pragma unroll
    for (unsigned j = 0; j < 16; ++j) { const unsigned c = xb_ld(&bar[XB_XCNT(j)]); sum += c; cnt += (c > 0u) ? 1u : 0u; mine = (j == x) ? c : mine; }
    if (sum == G) break;
    __builtin_amdgcn_s_sleep(1);
    if ((++sp & 255u) == 0u) { if (xb_ld(&bar[XB_TMO])) break; if (sp > XB_SPIN_CAP) { atomicAdd(&bar[XB_TMO], 1u); break; } }
  }
  nloc = mine > 0u ? mine : 1u; nx = cnt > 0u ? cnt : 1u;
}
DEV void xcd_barrier(const XcdBarrier& b) {
  asm volatile("s_waitcnt vmcnt(0)" ::: "memory");
  __syncthreads();
  if (threadIdx.x == 0) {
    unsigned* bar = b.bar;
    __builtin_amdgcn_s_waitcnt(0);
    unsigned nloc = b.st[0], nx = b.st[1];
    if (nloc == 0u) { xcd_barrier_complete(bar, b.x, nloc, nx); b.st[0] = nloc; b.st[1] = nx; }
    const unsigned old = xb_add(&bar[XB_XSUB(b.x)], 1u);
    const unsigned gen = old / nloc;
    if (old + 1u == (gen + 1u) * nloc) {
      __builtin_amdgcn_fence(__ATOMIC_RELEASE, "agent");
      asm volatile("s_waitcnt vmcnt(0)" ::: "memory");
      const unsigned og = xb_add(&bar[XB_TOP], 1u);
      const unsigned tg = og / nx;
      if (og + 1u == (tg + 1u) * nx) xb_add(&bar[XB_TOPGEN], 1u);
      else XB_SPIN(xb_ld(&bar[XB_TOPGEN]) == tg, bar);
      __builtin_amdgcn_fence(__ATOMIC_ACQUIRE, "agent");
      xb_add(&bar[XB_XGEN(b.x)], 1u);
      asm volatile("s_waitcnt vmcnt(0)" ::: "memory");
    } else {
      XB_SPIN(xb_ld(&bar[XB_XGEN(b.x)]) == gen, bar);
      __builtin_amdgcn_fence(__ATOMIC_ACQUIRE, "agent");
      asm volatile("s_waitcnt vmcnt(0)" ::: "memory");
    }
  }
  __syncthreads();
}

__global__ void __launch_bounds__(512, 2) mega(Params p) {
  extern __shared__ __attribute__((aligned(16))) unsigned char smem[];
  cg::grid_group grid = cg::this_grid();
  volatile LAS unsigned* xst = (volatile LAS unsigned*)(smem + LDS_MISC + 16);
  if (threadIdx.x == 0) { xst[0] = 0u; xst[1] = 0u; }
  __syncthreads();
  XcdBarrier xb = xcd_barrier_post((unsigned*)(p.ws + OFF_BAR), xst);
  if (p.ph_lo < 0) grid.sync();
  for (int ph = p.ph_lo; ph < p.ph_hi; ++ph) {
    if (ph == 0) {
      phase_prologue(p, smem);
    } else if (ph == NPH - 1) {
      phase_final(p);
    } else {
      const int layer = (ph - 1) / NSUB, sub = (ph - 1) % NSUB;
      const bf16_t* H = (const bf16_t*)(p.ws + OFF_H);
      const bf16_t* U = (const bf16_t*)(p.ws + OFF_U);
      const bf16_t* Yb = (const bf16_t*)(p.ws + OFF_Y);
      const bool last = layer == DEPTH - 1;
      const int ntm_post = last ? 128 : 136;
      switch (sub) {
        case 0: phase_norm(p, layer, 0, true, smem, MROWS); break;
        case 1: phase_ffn_up(p, W_UP1, smem, 136); break;
        case 2: phase_gemm_resid(p, U, FF, FF, W_DN1, layer, 2, 0.5f, smem, true); break;
        case 3: phase_norm(p, layer, 1, false, smem, MROWS); break;
        case 4: phase_mix(p, smem); break;
        case 5: phase_mixers(p, layer, smem); break;
        case 6: phase_gates(p, smem, ntm_post); phase_gla_final(p, layer); break;
        case 7: phase_merge(p, smem, ntm_post); break;
        case 8: phase_gemm_resid(p, Yb, D, D, W_OUT, layer, 5, 1.0f, smem, !last); break;
        case 9: phase_norm(p, layer, 2, false, smem, last ? NLAT : MROWS); break;
        case 10: phase_ffn_up(p, W_UP2, smem, ntm_post); break;
        default: phase_gemm_resid(p, U, FF, FF, W_DN2, layer, 8, 0.5f, smem, !last); break;
      }
      (void)H;
    }
    if (ph + 1 < p.ph_hi) xcd_barrier(xb);
  }
}

extern "C" void kernel_launch(void* const* d_in, const int* in_sizes, int n_in, void* d_out, int out_size, void* d_ws,
                              size_t ws_size, hipStream_t stream) {
  static int grid_blocks = 0;
  if (!grid_blocks) {
    if (ws_size < WS_NEED) fprintf(stderr, "kernel_launch: workspace too small: %zu < %zu\n", ws_size, (size_t)WS_NEED);
    hipFuncSetAttribute((const void*)mega, hipFuncAttributeMaxDynamicSharedMemorySize, LDS_BYTES);
    int dev = 0, cus = 0, per_cu = 0;
    hipGetDevice(&dev);
    hipDeviceGetAttribute(&cus, hipDeviceAttributeMultiprocessorCount, dev);
    hipOccupancyMaxActiveBlocksPerMultiprocessor(&per_cu, (const void*)mega, NTHR, LDS_BYTES);
    if (per_cu > 1) per_cu = 1;
    if (per_cu < 1) per_cu = 1;
    grid_blocks = cus * per_cu;
  }
  Params p{};
  const float** pp = (const float**)&p;
  for (int i = 0; i < 23; ++i) pp[i] = (const float*)d_in[i];
  p.out = (float*)d_out;
  p.ws = (unsigned char*)d_ws;
  p.ph_lo = 0;
  p.ph_hi = NPH;
  void* args[] = {&p};
  (void)hipMemsetAsync((unsigned char*)d_ws + OFF_BAR, 0, 3456 * 4, stream);
  (void)hipMemsetAsync((unsigned char*)d_ws + OFF_MOD, 0, (size_t)DEPTH * 9 * 9216 * 4, stream);
  hipError_t e = hipLaunchCooperativeKernel((const void*)mega, dim3(grid_blocks), dim3(NTHR), args, LDS_BYTES, stream);
  if (e != hipSuccess) fprintf(stderr, "cooperative launch failed: %s (grid %d)\n", hipGetErrorString(e), grid_blocks);
}
```

```cpp
#include <hip/hip_runtime.h>
#include <hip/hip_cooperative_groups.h>
#include <cstdio>
namespace cg = cooperative_groups;

typedef unsigned short bf16_t;
using bf16x8 = __attribute__((ext_vector_type(8))) short;
using f32x4  = __attribute__((ext_vector_type(4))) float;
using u32x4  = __attribute__((ext_vector_type(4))) unsigned;

#define DEV __device__ __forceinline__

constexpr int D = 1024, FF = 2816, NLAT = 32768, NCTX = 2048, MROWS = 34816, DEPTH = 4;
constexpr int PBW = 3232;
constexpr int PB_AQ = 0, PB_AK = 512, PB_BQ = 1024, PB_BK = 1280, PB_BV = 1536, PB_BR = 2048, PB_CQ = 2560, PB_CK = 3072, PB_LR = 3200;
constexpr int KVLEN = 4352;
constexpr int LDS_BYTES = 143360 + 64;
constexpr int LDS_MISC = 143360;
constexpr int NTHR = 512;
constexpr int NSUB = 12;
constexpr int NPH = 1 + NSUB * DEPTH + 1;

constexpr size_t OFF_XC   = 0;
constexpr size_t OFF_H    = OFF_XC + (size_t)NCTX * D * 4;
constexpr size_t OFF_U    = OFF_H + (size_t)MROWS * D * 2;
constexpr size_t OFF_W    = OFF_U + (size_t)MROWS * PBW * 2;
constexpr size_t W_ELEMS  = 27262976;
constexpr size_t OFF_VTA  = OFF_W + W_ELEMS * 2;
constexpr size_t OFF_VTC  = OFF_VTA + (size_t)8 * 4 * 128 * KVLEN * 2;
constexpr size_t OFF_O    = OFF_VTC + (size_t)8 * 2 * 64 * KVLEN * 2;
constexpr size_t OFF_OFB  = OFF_O + (size_t)MROWS * 1536 * 2;
constexpr size_t OFF_MOD  = OFF_OFB + (size_t)2 * MROWS * 512 * 2;
constexpr size_t OFF_ROPE = OFF_MOD + (size_t)DEPTH * 9 * 9216 * 4;
constexpr size_t OFF_MISC = OFF_ROPE + 8192;
constexpr size_t OFF_BAR  = OFF_MISC + 256;
constexpr size_t OFF_Y    = OFF_BAR + 16384;
constexpr size_t OFF_BR   = OFF_Y + (size_t)MROWS * D * 2;
constexpr size_t WS_NEED  = OFF_BR + (size_t)MROWS * 512 * 2;

constexpr size_t W_UP1 = 0, W_DN1 = 5767168, W_UP2 = 8650752, W_DN2 = 14417920, W_MIX = 17301504,
                 W_G = 21495808, W_BRA = 24641536, W_BRB = 25165824, W_BRC = 25690112, W_OUT = 26214400;

struct Params {
  const float *x, *c, *ctx, *c_ctx, *w_ada, *b_ada, *norm_g, *w_ffn1_in, *w_ffn1_out, *w_ffn2_in, *w_ffn2_out,
              *w_mix_in, *diff_lambda, *diff_subln, *gla_gate_w, *gla_gate_b, *gla_norm, *swa_sink,
              *w_br_a, *w_br_b, *w_br_c, *w_mix_out, *final_g;
  float* out;
  unsigned char* ws;
  int ph_lo, ph_hi;
};

DEV int otid() { int t = threadIdx.x; asm volatile("" : "+v"(t)); return t; }
typedef __bf16 hbf16x2_t __attribute__((ext_vector_type(2)));
typedef float hf32x2_t __attribute__((ext_vector_type(2)));
DEV unsigned short f2bf(float f) { const __bf16 h = (__bf16)f; return __builtin_bit_cast(unsigned short, h); }
DEV float bf2f(unsigned short b) { return __uint_as_float(((unsigned)b) << 16); }
DEV unsigned pack2(float a, float b) { const hf32x2_t v = {a, b}; return __builtin_bit_cast(unsigned, __builtin_convertvector(v, hbf16x2_t)); }
DEV float sigmoidf_(float x) { return 1.f / (1.f + __expf(-x)); }
DEV float siluf_(float x) { return x / (1.f + __expf(-x)); }
DEV f32x4 mfma16(bf16x8 a, bf16x8 b, f32x4 c) { return __builtin_amdgcn_mfma_f32_16x16x32_bf16(a, b, c, 0, 0, 0); }
DEV int mod_bp(int m) { return m < NLAT ? (m >> 12) : 8; }
DEV float* xrow_ptr(const Params& p, int m) {
  return m < NLAT ? p.out + (size_t)m * D : (float*)(p.ws + OFF_XC) + (size_t)(m - NLAT) * D;
}

template <int NI, bool TRANS>
DEV void gemm_compute(f32x4 (&acc)[NI][8], const bf16_t* pa, const bf16_t* pb, int lr, int lg) {
#pragma unroll
  for (int ks = 0; ks < 2; ++ks) {
    bf16x8 bfr[NI];
    const int so = ((ks * 4 + lg) ^ (lr & 7)) * 8;
#pragma unroll
    for (int ni = 0; ni < NI; ++ni) bfr[ni] = *(const bf16x8*)(pb + ni * 16 * 64 + so);
#pragma unroll
    for (int mh = 0; mh < 2; ++mh) {
      bf16x8 af[4];
#pragma unroll
      for (int mi = 0; mi < 4; ++mi) af[mi] = *(const bf16x8*)(pa + (mh * 4 + mi) * 16 * 64 + so);
#pragma unroll
      for (int ni = 0; ni < NI; ++ni)
#pragma unroll
        for (int mi = 0; mi < 4; ++mi)
          acc[ni][mh * 4 + mi] = TRANS ? mfma16(bfr[ni], af[mi], acc[ni][mh * 4 + mi]) : mfma16(af[mi], bfr[ni], acc[ni][mh * 4 + mi]);
    }
  }
}

#define GL_LAS __attribute__((address_space(3)))
#define GL_BARRIER() do { asm volatile("s_waitcnt lgkmcnt(0)" ::: "memory"); __builtin_amdgcn_s_barrier(); asm volatile("" ::: "memory"); } while (0)
template <bool TRANS>
DEV void gemm_kloop_glds4(f32x4 (&acc)[4][8], const bf16_t* __restrict__ Ag, int lda, const bf16_t* __restrict__ Bg, int ldb,
                          int K, unsigned char* smem) {
  const int tid = otid(), lane = tid & 63, wave = tid >> 6, wm = wave >> 2, wn = wave & 3;
  const int lr = lane & 15, lg = lane >> 4;
  const int KT2 = K >> 5;
  const int grow = lane >> 2, gpos = lane & 3;
  const int gsw = (0x78 >> (((grow >> 2) & 3) * 2)) & 3;
  const bf16_t* asrc = Ag + (size_t)(wave * 16 + grow) * lda + ((gpos ^ gsw) * 8);
  const bf16_t* bsrc = Bg + (size_t)(wave * 16 + grow) * ldb + ((gpos ^ gsw) * 8);
  unsigned char* ldsw = smem + wave * 1024;
#define GL_TILE(J)                                                                                          \
  {                                                                                                        \
    const int st_ = (J) & 3, k0_ = (J) << 5;                                                               \
    _Pragma("unroll") for (int i = 0; i < 2; ++i) {                                                        \
      __builtin_amdgcn_global_load_lds((const unsigned*)(asrc + (size_t)(i * 128) * lda + k0_),            \
                                       (GL_LAS unsigned*)(ldsw + st_ * 32768 + i * 8192), 16, 0, 0);       \
      __builtin_amdgcn_global_load_lds((const unsigned*)(bsrc + (size_t)(i * 128) * ldb + k0_),            \
                                       (GL_LAS unsigned*)(ldsw + st_ * 32768 + 16384 + i * 8192), 16, 0, 0); \
    }                                                                                                      \
  }
  const int rsw = (0x78 >> (((lr >> 2) & 3) * 2)) & 3;
  const bf16_t* pa = (const bf16_t*)smem + (wm * 128 + lr) * 32 + ((lg ^ rsw) * 8);
  const bf16_t* pb = (const bf16_t*)(smem + 16384) + (wn * 64 + lr) * 32 + ((lg ^ rsw) * 8);
  GL_TILE(0);
  GL_TILE(1);
  GL_TILE(2);
  for (int j = 0; j < KT2; ++j) {
    if (j + 2 < KT2) asm volatile("s_waitcnt vmcnt(8)" ::: "memory");
    else if (j + 1 < KT2) asm volatile("s_waitcnt vmcnt(4)" ::: "memory");
    else asm volatile("s_waitcnt vmcnt(0)" ::: "memory");
    GL_BARRIER();
    if (j + 3 < KT2) GL_TILE(j + 3);
    const bf16_t* qa = pa + (j & 3) * 16384;
    const bf16_t* qb = pb + (j & 3) * 16384;
    bf16x8 bfr[4];
#pragma unroll
    for (int ni = 0; ni < 4; ++ni) bfr[ni] = *(const bf16x8*)(qb + ni * 16 * 32);
#pragma unroll
    for (int mh = 0; mh < 2; ++mh) {
      bf16x8 af[4];
#pragma unroll
      for (int mi = 0; mi < 4; ++mi) af[mi] = *(const bf16x8*)(qa + (mh * 4 + mi) * 16 * 32);
#pragma unroll
      for (int ni = 0; ni < 4; ++ni)
#pragma unroll
        for (int mi = 0; mi < 4; ++mi)
          acc[ni][mh * 4 + mi] = TRANS ? mfma16(bfr[ni], af[mi], acc[ni][mh * 4 + mi]) : mfma16(af[mi], bfr[ni], acc[ni][mh * 4 + mi]);
    }
  }
  GL_BARRIER();
#undef GL_TILE
}

template <bool TRANS>
DEV void gemm_kloop_glds64(f32x4 (&acc)[4][8], const bf16_t* __restrict__ Ag, int lda, const bf16_t* __restrict__ Bg, int ldb,
                           int K, unsigned char* smem, bool primed) {
  const int tid = otid(), lane = tid & 63, wave = tid >> 6, wm = wave >> 2, wn = wave & 3;
  const int lr = lane & 15, lg = lane >> 4;
  const int KT = K >> 6;
  const int grow = lane >> 3, gpos = lane & 7;
  const bf16_t* asrc = Ag + (size_t)(wave * 8 + grow) * lda + ((gpos ^ grow) * 8);
  const bf16_t* bsrc = Bg + (size_t)(wave * 8 + grow) * ldb + ((gpos ^ grow) * 8);
  unsigned char* ldsw = smem + wave * 1024;
#define GL64_TILE(J)                                                                                        \
  {                                                                                                        \
    const int st_ = (J) & 1, k0_ = (J) << 6;                                                               \
    _Pragma("unroll") for (int i = 0; i < 4; ++i) {                                                        \
      __builtin_amdgcn_global_load_lds((const unsigned*)(asrc + (size_t)(i * 64) * lda + k0_),             \
                                       (GL_LAS unsigned*)(ldsw + st_ * 65536 + i * 8192), 16, 0, 0);       \
      __builtin_amdgcn_global_load_lds((const unsigned*)(bsrc + (size_t)(i * 64) * ldb + k0_),             \
                                       (GL_LAS unsigned*)(ldsw + st_ * 65536 + 32768 + i * 8192), 16, 0, 0); \
    }                                                                                                      \
  }
  const bf16_t* pa = (const bf16_t*)smem + (wm * 128 + lr) * 64;
  const bf16_t* pb = (const bf16_t*)(smem + 32768) + (wn * 64 + lr) * 64;
  if (!primed) GL64_TILE(0);
  for (int j = 0; j < KT; ++j) {
    asm volatile("s_waitcnt vmcnt(0)" ::: "memory");
    GL_BARRIER();
    const bf16_t* qa = pa + (j & 1) * 32768;
    const bf16_t* qb = pb + (j & 1) * 32768;
    bf16x8 bf0[4], af0[8], bf1[4], af1[4];
    const int so0 = (lg ^ (lr & 7)) * 8, so1 = ((4 + lg) ^ (lr & 7)) * 8;
#pragma unroll
    for (int ni = 0; ni < 4; ++ni) bf0[ni] = *(const bf16x8*)(qb + ni * 16 * 64 + so0);
#pragma unroll
    for (int mi = 0; mi < 8; ++mi) af0[mi] = *(const bf16x8*)(qa + mi * 16 * 64 + so0);
    __builtin_amdgcn_sched_barrier(0);
    if (j + 1 < KT) GL64_TILE(j + 1);
    __builtin_amdgcn_sched_barrier(0);
#pragma unroll
    for (int ni = 0; ni < 4; ++ni) bf1[ni] = *(const bf16x8*)(qb + ni * 16 * 64 + so1);
#pragma unroll
    for (int mi = 0; mi < 4; ++mi) af1[mi] = *(const bf16x8*)(qa + mi * 16 * 64 + so1);
    __builtin_amdgcn_sched_barrier(0);
#pragma unroll
    for (int mi = 0; mi < 8; ++mi)
#pragma unroll
      for (int ni = 0; ni < 4; ++ni)
        acc[ni][mi] = TRANS ? mfma16(bf0[ni], af0[mi], acc[ni][mi]) : mfma16(af0[mi], bf0[ni], acc[ni][mi]);
    bf16x8 af2[4];
#pragma unroll
    for (int mi = 0; mi < 4; ++mi) af2[mi] = *(const bf16x8*)(qa + (4 + mi) * 16 * 64 + so1);
#pragma unroll
    for (int mi = 0; mi < 4; ++mi)
#pragma unroll
      for (int ni = 0; ni < 4; ++ni)
        acc[ni][mi] = TRANS ? mfma16(bf1[ni], af1[mi], acc[ni][mi]) : mfma16(af1[mi], bf1[ni], acc[ni][mi]);
#pragma unroll
    for (int mi = 0; mi < 4; ++mi)
#pragma unroll
      for (int ni = 0; ni < 4; ++ni)
        acc[ni][4 + mi] = TRANS ? mfma16(bf1[ni], af2[mi], acc[ni][4 + mi]) : mfma16(af2[mi], bf1[ni], acc[ni][4 + mi]);
  }
  GL_BARRIER();
#undef GL64_TILE
}

DEV void glds64_prime(const bf16_t* __restrict__ Ag, int lda, const bf16_t* __restrict__ Bg, int ldb, unsigned char* smem) {
  const int tid = otid(), lane = tid & 63, wave = tid >> 6;
  const int grow = lane >> 3, gpos = lane & 7;
  const bf16_t* asrc = Ag + (size_t)(wave * 8 + grow) * lda + ((gpos ^ grow) * 8);
  const bf16_t* bsrc = Bg + (size_t)(wave * 8 + grow) * ldb + ((gpos ^ grow) * 8);
  unsigned char* ldsw = smem + wave * 1024;
#pragma unroll
  for (int i = 0; i < 4; ++i) {
    __builtin_amdgcn_global_load_lds((const unsigned*)(asrc + (size_t)(i * 64) * lda), (GL_LAS unsigned*)(ldsw + i * 8192), 16, 0, 0);
    __builtin_amdgcn_global_load_lds((const unsigned*)(bsrc + (size_t)(i * 64) * ldb), (GL_LAS unsigned*)(ldsw + 32768 + i * 8192), 16, 0, 0);
  }
}

template <int NI, bool TRANS, bool DEEP = (NI == 2)>
DEV void gemm_kloop(f32x4 (&acc)[NI][8], const bf16_t* __restrict__ Ag, int lda, const bf16_t* __restrict__ Bg, int ldb,
                    int K, unsigned char* smem, bool primed = false) {
  if constexpr (NI == 4) { gemm_kloop_glds64<TRANS>(acc, Ag, lda, Bg, ldb, K, smem, primed); return; }
  bf16_t* sA = (bf16_t*)smem;
  bf16_t* sB = (bf16_t*)(smem + 32768);
  const int tid = otid(), lane = tid & 63, wave = tid >> 6, wm = wave >> 2, wn = wave & 3;
  const int lr = lane & 15, lg = lane >> 4;
  const int crow = tid >> 3, ccol = (tid & 7) * 8;
  const int scol = ((tid & 7) ^ (crow & 7)) * 8;
  const bf16_t* ap = Ag + (size_t)crow * lda + ccol;
  const bf16_t* bp = Bg + (size_t)crow * ldb + ccol;
  const int KT = K >> 6;
  const bf16_t* pa = sA + (wm * 128 + lr) * 64;
  const bf16_t* pb = sB + (wn * NI * 16 + lr) * 64;
#define G_LOAD(RA, RB, K0)                                                                                 \
  {                                                                                                       \
    _Pragma("unroll") for (int i = 0; i < 4; ++i) RA[i] = *(const u32x4*)(ap + (size_t)(64 * i) * lda + (K0)); \
    _Pragma("unroll") for (int i = 0; i < NI; ++i) RB[i] = *(const u32x4*)(bp + (size_t)(64 * i) * ldb + (K0)); \
  }
#define G_STORE(RA, RB, BUF)                                                                               \
  {                                                                                                       \
    _Pragma("unroll") for (int i = 0; i < 4; ++i) *(u32x4*)(sA + (BUF) * 32768 + (crow + 64 * i) * 64 + scol) = RA[i]; \
    _Pragma("unroll") for (int i = 0; i < NI; ++i) *(u32x4*)(sB + (BUF) * 32768 + (crow + 64 * i) * 64 + scol) = RB[i]; \
  }
  if constexpr (DEEP) {
    u32x4 ra0[4], rb0[NI], ra1[4], rb1[NI];
    G_LOAD(ra0, rb0, 0);
    G_LOAD(ra1, rb1, 64);
    G_STORE(ra0, rb0, 0);
    __syncthreads();
    for (int kt = 0; kt < KT; kt += 2) {
      if (kt + 2 < KT) G_LOAD(ra0, rb0, (kt + 2) << 6);
      gemm_compute<NI, TRANS>(acc, pa, pb, lr, lg);
      G_STORE(ra1, rb1, 1);
      __syncthreads();
      if (kt + 3 < KT) G_LOAD(ra1, rb1, (kt + 3) << 6);
      gemm_compute<NI, TRANS>(acc, pa + 32768, pb + 32768, lr, lg);
      if (kt + 2 < KT) G_STORE(ra0, rb0, 0);
      __syncthreads();
    }
  } else {
    u32x4 ra[4], rb[NI];
    G_LOAD(ra, rb, 0);
    G_STORE(ra, rb, 0);
    __syncthreads();
    for (int kt = 0; kt < KT; ++kt) {
      const int buf = kt & 1;
      if (kt + 1 < KT) G_LOAD(ra, rb, (kt + 1) << 6);
      gemm_compute<NI, TRANS>(acc, pa + buf * 32768, pb + buf * 32768, lr, lg);
      if (kt + 1 < KT) G_STORE(ra, rb, buf ^ 1);
      __syncthreads();
    }
  }
#undef G_LOAD
#undef G_STORE
}

DEV bool tile_map(int w, int ntm, int ntn_pad, int sm, int sn, int& tm, int& tn) {
  const int per = sm * sn;
  const int x = w & 7, j = w >> 3;
  const int nsn = ntn_pad / sn;
  const int nsup = (ntm / sm) * nsn;
  const int lo = (x * nsup) >> 3, hi = ((x + 1) * nsup) >> 3;
  const int sup = lo + j / per, within = j % per;
  if (sup >= hi) return false;
  tm = (sup / nsn) * sm + within / sn;
  tn = (sup % nsn) * sn + within % sn;
  return true;
}
DEV int tile_slots(int ntm, int ntn_pad, int sm, int sn) {
  const int nsup = (ntm / sm) * (ntn_pad / sn);
  return ((nsup + 7) / 8) * 8 * sm * sn;
}
DEV int next_slot(int t, int nslots, int ntm, int ntn_pad, int sm, int sn, int& tm, int& tn) {
  while (t < nslots && !tile_map(t, ntm, ntn_pad, sm, sn, tm, tn)) t += gridDim.x;
  return t < nslots ? t : nslots;
}

template <int NI>
DEV void zero_acc(f32x4 (&acc)[NI][8]) {
#pragma unroll
  for (int ni = 0; ni < NI; ++ni)
#pragma unroll
    for (int mi = 0; mi < 8; ++mi) acc[ni][mi] = f32x4{0.f, 0.f, 0.f, 0.f};
}

DEV const float* xin_ptr(const Params& p, int m) {
  return m < NLAT ? p.x + (size_t)m * D : p.ctx + (size_t)(m - NLAT) * D;
}
template <int NI>
DEV void epi_resid(const Params& p, f32x4 (&acc)[NI][8], int m0, int n0, int layer, int slot, float coef) {
  const int tid_ = otid(); const int lane = tid_ & 63, wave = tid_ >> 6, wm = wave >> 2, wn = wave & 3, lr = lane & 15, lg = lane >> 4;
  const float* modv = (const float*)(p.ws + OFF_MOD) + (size_t)layer * 9 * 9216 + slot * 1024;
#pragma unroll
  for (int mi = 0; mi < 8; ++mi) {
    const int m = m0 + wm * 128 + mi * 16 + lr;
    float* xr = xrow_ptr(p, m);
    const float* xs = (layer == 0 && slot == 2) ? xin_ptr(p, m) : xr;
    const float* mv = modv + (size_t)mod_bp(m) * 9216;
#pragma unroll
    for (int ni = 0; ni < NI; ++ni) {
      const int n = n0 + wn * NI * 16 + ni * 16 + lg * 4;
      float4 xv = *(const float4*)(xs + n);
      const float4 g = *(const float4*)(mv + n);
      xv.x += coef * g.x * acc[ni][mi][0];
      xv.y += coef * g.y * acc[ni][mi][1];
      xv.z += coef * g.z * acc[ni][mi][2];
      xv.w += coef * g.w * acc[ni][mi][3];
      *(float4*)(xr + n) = xv;
    }
  }
}

DEV int srccol_map(int mt, int n) {
  if (mt == 0) return n;
  if (mt == 1) { const int qd = n >> 5, r = n & 31; return r < 16 ? 16 * qd + r : FF + 16 * qd + (r - 16); }
  if (mt == 2) return n < 2560 ? n : (n < 3712 ? n + 32 : (n < 3744 ? n - 1152 : (n < 3840 ? -1 : (n < 3968 ? n - 96 : -1))));
  return 3872 + n;
}

DEV void convert_tile(const float* __restrict__ src, int ld, int K, int mt, bf16_t* __restrict__ dst, int tile, unsigned char* smem) {
  const int tid = otid() & 255;
  float* t = (float*)(smem + (otid() >> 8) * 16640);
  const int KT = K >> 6;
  const int kt = tile % KT, nt = tile / KT;
  {
    const int j = tid & 63, i0 = tid >> 6;
    const int sc = srccol_map(mt, nt * 64 + j);
#pragma unroll
    for (int ii = 0; ii < 16; ++ii) {
      const int i = i0 + 4 * ii;
      t[i * 65 + j] = sc >= 0 ? src[(size_t)(kt * 64 + i) * ld + sc] : 0.f;
    }
  }
  __syncthreads();
  {
    const int i = (tid & 7) * 8, j0 = tid >> 3;
#pragma unroll
    for (int jj = 0; jj < 2; ++jj) {
      const int j = j0 + 32 * jj;
      uint4 v;
      v.x = pack2(t[(i + 0) * 65 + j], t[(i + 1) * 65 + j]);
      v.y = pack2(t[(i + 2) * 65 + j], t[(i + 3) * 65 + j]);
      v.z = pack2(t[(i + 4) * 65 + j], t[(i + 5) * 65 + j]);
      v.w = pack2(t[(i + 6) * 65 + j], t[(i + 7) * 65 + j]);
      *(uint4*)(dst + (size_t)(nt * 64 + j) * K + kt * 64 + i) = v;
    }
  }
  __syncthreads();
}

constexpr int CONV_TILES = 6656;
DEV void convert_item(const Params& p, int layer, int t, unsigned char* smem) {
  bf16_t* W = (bf16_t*)(p.ws + OFF_W);
  if (t < 1408) { convert_tile(p.w_ffn1_in + (size_t)layer * D * 2 * FF, 2 * FF, D, 1, W + W_UP1, t, smem); return; }
  t -= 1408;
  if (t < 704) { convert_tile(p.w_ffn1_out + (size_t)layer * FF * D, D, FF, 0, W + W_DN1, t, smem); return; }
  t -= 704;
  if (t < 1408) { convert_tile(p.w_ffn2_in + (size_t)layer * D * 2 * FF, 2 * FF, D, 1, W + W_UP2, t, smem); return; }
  t -= 1408;
  if (t < 704) { convert_tile(p.w_ffn2_out + (size_t)layer * FF * D, D, FF, 0, W + W_DN2, t, smem); return; }
  t -= 704;
  if (t < 1024) { convert_tile(p.w_mix_in + (size_t)layer * D * 6944, 6944, D, 2, W + W_MIX, t, smem); return; }
  t -= 1024;
  if (t < 768) { convert_tile(p.w_mix_in + (size_t)layer * D * 6944, 6944, D, 3, W + W_G, t, smem); return; }
  t -= 768;
  if (t < 128) { convert_tile(p.w_br_a + (size_t)layer * 512 * D, D, 512, 0, W + W_BRA, t, smem); return; }
  t -= 128;
  if (t < 128) { convert_tile(p.w_br_b + (size_t)layer * 512 * D, D, 512, 0, W + W_BRB, t, smem); return; }
  t -= 128;
  if (t < 128) { convert_tile(p.w_br_c + (size_t)layer * 512 * D, D, 512, 0, W + W_BRC, t, smem); return; }
  t -= 128;
  convert_tile(p.w_mix_out + (size_t)layer * D * D, D, D, 0, W + W_OUT, t, smem);
}

DEV void mod_item(const Params& p, int item, unsigned char* smem) {
  float* sc = (float*)smem;
  const int tid = otid();
  const int kp = item & 3, lj = item >> 2;
  const int layer = lj / 18, jb = lj % 18;
  for (int i = tid; i < 9 * 256; i += NTHR) {
    const int bp = i >> 8, k = kp * 256 + (i & 255);
    const float v = bp < 8 ? p.c[bp * 1024 + k] : p.c_ctx[k];
    sc[i] = siluf_(v);
  }
  __syncthreads();
  const int j = jb * NTHR + tid;
  float acc[9];
#pragma unroll
  for (int b = 0; b < 9; ++b) acc[b] = 0.f;
  const float* w = p.w_ada + ((size_t)layer * D + kp * 256) * 9216 + j;
#pragma unroll 2
  for (int k = 0; k < 256; k += 4) {
    const float w0 = w[(size_t)(k + 0) * 9216], w1 = w[(size_t)(k + 1) * 9216], w2 = w[(size_t)(k + 2) * 9216], w3 = w[(size_t)(k + 3) * 9216];
#pragma unroll
    for (int b = 0; b < 9; ++b) {
      const float4 s4 = *(const float4*)(sc + b * 256 + k);
      acc[b] += s4.x * w0 + s4.y * w1 + s4.z * w2 + s4.w * w3;
    }
  }
  float* modv = (float*)(p.ws + OFF_MOD) + (size_t)layer * 9 * 9216;
  const float bb = kp == 0 ? p.b_ada[layer * 9216 + j] : 0.f;
#pragma unroll
  for (int b = 0; b < 9; ++b) atomicAdd(modv + (size_t)b * 9216 + j, acc[b] + bb);
  __syncthreads();
}

DEV void phase_prologue(const Params& p, unsigned char* smem) {
  const int tid = otid();
  const int nitems = 288 + 1;
  for (int it = blockIdx.x; it < nitems; it += gridDim.x) {
    if (it < 288) {
      mod_item(p, it, smem);
    } else if (it == 288) {
      float* rope = (float*)(p.ws + OFF_ROPE);
      for (int i = tid; i < 1024; i += NTHR) {
        const int pos = i >> 4, fi = i & 15;
        const float freq = powf(10000.0f, -(float)fi / 16.0f);
        const float ang = (float)pos * freq;
        rope[i] = cosf(ang);
        rope[1024 + i] = sinf(ang);
      }
      if (tid < DEPTH) {
        const float* lp = p.diff_lambda + tid * 256;
        float s01 = 0.f, s23 = 0.f;
        for (int i = 0; i < 64; ++i) { s01 += lp[i] * lp[64 + i]; s23 += lp[128 + i] * lp[192 + i]; }
        const float lam_init = 0.8f - 0.6f * expf(-0.3f * (float)tid);
        ((float*)(p.ws + OFF_MISC))[tid] = expf(s01) - expf(s23) + lam_init;
        ((int*)(p.ws + OFF_MISC + 64))[tid] = 0;
      }
    } else {
      const int r0 = (it - 289) * 32;
      for (int i = tid; i < 32 * 256; i += NTHR) {
        const int m = r0 + (i >> 8), c4 = (i & 255) * 4;
        const float4 v = m < NLAT ? *(const float4*)(p.x + (size_t)m * D + c4) : *(const float4*)(p.ctx + (size_t)(m - NLAT) * D + c4);
        *(float4*)(xrow_ptr(p, m) + c4) = v;
      }
    }
  }
}

DEV void phase_norm(const Params& p, int layer, int which, bool conv, unsigned char* smem, int nrows) {
  const int tid = otid(), lane = tid & 63, wave = tid >> 6;
  const int nconv = conv ? CONV_TILES / 2 : 0;
  bf16_t* H = (bf16_t*)(p.ws + OFF_H);
  const float* g = p.norm_g + (size_t)(layer * 3 + which) * D;
  for (int it = blockIdx.x; it < nconv; it += gridDim.x) convert_item(p, layer, it * 2 + (tid >> 8), smem);
  {
    const int nw = gridDim.x * 8, rpw = (nrows + nw - 1) / nw;
    const int r0 = (blockIdx.x * 8 + wave) * rpw;
    for (int rr = 0; rr < rpw; ++rr) {
      const int m = r0 + rr;
      if (m >= nrows) break;
      const float* xr = (layer == 0 && which == 0) ? xin_ptr(p, m) : xrow_ptr(p, m);
      const float* mv = (const float*)(p.ws + OFF_MOD) + ((size_t)layer * 9 + mod_bp(m)) * 9216 + (3 * which) * 1024;
      float4 v[4];
      float ss = 0.f;
#pragma unroll
      for (int q = 0; q < 4; ++q) {
        v[q] = *(const float4*)(xr + q * 256 + lane * 4);
        ss += v[q].x * v[q].x + v[q].y * v[q].y + v[q].z * v[q].z + v[q].w * v[q].w;
      }
#pragma unroll
      for (int o = 32; o >= 1; o >>= 1) ss += __shfl_xor(ss, o);
      const float rstd = rsqrtf(ss * (1.f / 1024.f) + 1e-6f);
#pragma unroll
      for (int q = 0; q < 4; ++q) {
        const int cidx = q * 256 + lane * 4;
        const float4 gg = *(const float4*)(g + cidx);
        const float4 sh = *(const float4*)(mv + cidx);
        const float4 sc = *(const float4*)(mv + 1024 + cidx);
        const float a0 = (v[q].x * rstd * gg.x) * (1.f + sc.x) + sh.x;
        const float a1 = (v[q].y * rstd * gg.y) * (1.f + sc.y) + sh.y;
        const float a2 = (v[q].z * rstd * gg.z) * (1.f + sc.z) + sh.z;
        const float a3 = (v[q].w * rstd * gg.w) * (1.f + sc.w) + sh.w;
        uint2 o2; o2.x = pack2(a0, a1); o2.y = pack2(a2, a3);
        *(uint2*)(H + (size_t)m * D + cidx) = o2;
      }
    }
  }
}

DEV void phase_ffn_up(const Params& p, size_t woff, unsigned char* smem, int ntm) {
  const bf16_t* H = (const bf16_t*)(p.ws + OFF_H);
  const bf16_t* W = (const bf16_t*)(p.ws + OFF_W) + woff;
  bf16_t* hid = (bf16_t*)(p.ws + OFF_U);
  const int tid_ = otid(); const int lane = tid_ & 63, wave = tid_ >> 6, wm = wave >> 2, wn = wave & 3, lr = lane & 15, lg = lane >> 4;
  const int nslots = tile_slots(ntm, 22, 8, 2);
  int tm, tn, tm2 = 0, tn2 = 0;
  bool primed = false;
  for (int t = next_slot(blockIdx.x, nslots, ntm, 22, 8, 2, tm, tn); t < nslots;) {
    const int m0 = tm * 256, n0 = tn * 256;
    f32x4 acc[4][8];
    zero_acc<4>(acc);
    gemm_kloop<4, true>(acc, H + (size_t)m0 * D, D, W + (size_t)n0 * D, D, D, smem, primed);
    t = next_slot(t + gridDim.x, nslots, ntm, 22, 8, 2, tm2, tn2);
    primed = t < nslots;
    if (primed) glds64_prime(H + (size_t)tm2 * 256 * D, D, W + (size_t)tn2 * 256 * D, D, smem);
    tm = tm2; tn = tn2;
#pragma unroll
    for (int mi = 0; mi < 8; ++mi) {
      const int m = m0 + wm * 128 + mi * 16 + lr;
#pragma unroll
      for (int q = 0; q < 2; ++q) {
        const int hc = ((n0 + wn * 64) >> 1) + 16 * q + lg * 4;
        float r[4];
#pragma unroll
        for (int i = 0; i < 4; ++i) r[i] = siluf_(acc[2 * q][mi][i]) * acc[2 * q + 1][mi][i];
        uint2 o2; o2.x = pack2(r[0], r[1]); o2.y = pack2(r[2], r[3]);
        *(uint2*)(hid + (size_t)m * FF + hc) = o2;
      }
    }
  }
}

DEV void phase_gemm_resid(const Params& p, const bf16_t* A, int lda, int K, size_t woff, int layer, int slot, float coef, unsigned char* smem, bool tail) {
  const bf16_t* W = (const bf16_t*)(p.ws + OFF_W) + woff;
  const int nslots = tile_slots(128, 4, 8, 4);
  int tm, tn, tm2 = 0, tn2 = 0;
  bool primed = false;
  for (int t = next_slot(blockIdx.x, nslots, 128, 4, 8, 4, tm, tn); t < nslots;) {
    const int m0 = tm * 256, n0 = tn * 256;
    f32x4 acc[4][8];
    zero_acc<4>(acc);
    gemm_kloop<4, true>(acc, A + (size_t)m0 * lda, lda, W + (size_t)n0 * K, K, K, smem, primed);
    t = next_slot(t + gridDim.x, nslots, 128, 4, 8, 4, tm2, tn2);
    primed = t < nslots;
    if (primed) glds64_prime(A + (size_t)tm2 * 256 * lda, lda, W + (size_t)tn2 * 256 * K, K, smem);
    epi_resid<4>(p, acc, m0, n0, layer, slot, coef);
    tm = tm2; tn = tn2;
  }
  if (tail) {
    for (int u = blockIdx.x; u < 128; u += gridDim.x) {
      const int m0 = (128 + (u >> 4)) * 256, n0 = (u & 15) * 64;
      f32x4 acc[1][8];
      zero_acc<1>(acc);
      gemm_kloop<1, true, true>(acc, A + (size_t)m0 * lda, lda, W + (size_t)n0 * K, K, K, smem);
      epi_resid<1>(p, acc, m0, n0, layer, slot, coef);
    }
  }
}

DEV void phase_mix(const Params& p, unsigned char* smem) {
  const bf16_t* H = (const bf16_t*)(p.ws + OFF_H);
  const bf16_t* W = (const bf16_t*)(p.ws + OFF_W) + W_MIX;
  bf16_t* PB = (bf16_t*)(p.ws + OFF_U);
  bf16_t* VtA = (bf16_t*)(p.ws + OFF_VTA);
  bf16_t* VtC = (bf16_t*)(p.ws + OFF_VTC);
  const float* rope = (const float*)(p.ws + OFF_ROPE);
  const int tid_ = otid(); const int lane = tid_ & 63, wave = tid_ >> 6, wm = wave >> 2, wn = wave & 3, lr = lane & 15, lg = lane >> 4;
  const int nslots = tile_slots(136, 16, 8, 4);
  int tm_, tn_, tm2 = 0, tn2 = 0;
  bool primed = false;
#define MIX_ADVANCE()                                                                                       \
  {                                                                                                        \
    t = next_slot(t + gridDim.x, nslots, 136, 16, 8, 4, tm2, tn2);                                         \
    primed = t < nslots;                                                                                   \
    if (primed) glds64_prime(H + (size_t)tm2 * 256 * D, D, W + (size_t)tn2 * 256 * D, D, smem);            \
    tm_ = tm2; tn_ = tn2;                                                                                  \
  }
  for (int t = next_slot(blockIdx.x, nslots, 136, 16, 8, 4, tm_, tn_); t < nslots;) {
    const int tm = tm_, tn = tn_;
    const int m0 = tm * 256, n0 = tn * 256;
    const bool vtile = (tn == 4) || (tn == 5) || (tn == 15);
    f32x4 acc[4][8];
    zero_acc<4>(acc);
    if (vtile) {
      gemm_kloop<4, false>(acc, H + (size_t)m0 * D, D, W + (size_t)n0 * D, D, D, smem, primed);
      MIX_ADVANCE();
      if (tn == 15 && wn >= 2) continue;
#pragma unroll
      for (int mi = 0; mi < 8; ++mi) {
        const int m = m0 + wm * 128 + mi * 16 + lg * 4;
        int b, pos;
        if (m < NLAT) { b = m >> 12; pos = m & 4095; } else { const int mc = m - NLAT; b = mc >> 8; pos = 4096 + (mc & 255); }
#pragma unroll
        for (int ni = 0; ni < 4; ++ni) {
          const int n = n0 + wn * 64 + ni * 16 + lr;
          uint2 o2; o2.x = pack2(acc[ni][mi][0], acc[ni][mi][1]); o2.y = pack2(acc[ni][mi][2], acc[ni][mi][3]);
          if (tn == 15) {
            const int ea = n - 3840, kvh = ea >> 6, e = ea & 63;
            *(uint2*)(VtC + ((size_t)((b * 2 + kvh) * 64 + e)) * KVLEN + pos) = o2;
          } else {
            const int ea = n - 1024, hh = ea >> 7, e = ea & 127;
            *(uint2*)(VtA + ((size_t)((b * 4 + hh) * 128 + e)) * KVLEN + pos) = o2;
          }
        }
      }
    } else {
      gemm_kloop<4, true>(acc, H + (size_t)m0 * D, D, W + (size_t)n0 * D, D, D, smem, primed);
      MIX_ADVANCE();
      const int gcol = tn * 4 + wn;
      if (gcol == 59) continue;
      const bool do_rope = (gcol < 16) || (gcol >= 48 && gcol < 58);
      const float scl = (gcol < 8 || (gcol >= 48 && gcol < 56)) ? 0.125f * 1.44269504089f : 1.f;
      const int delta = gcol < 16 ? 0 : 512;
#pragma unroll
      for (int mi = 0; mi < 8; ++mi) {
        const int m = m0 + wm * 128 + mi * 16 + lr;
        if (do_rope && m < NLAT) {
          int tpos = m & 4095;
          asm volatile("" : "+v"(tpos));
#pragma unroll
          for (int pr = 0; pr < 2; ++pr) {
            const int pp = pr == 0 ? (tpos >> 6) : (tpos & 63);
            const float4 cs = *(const float4*)(rope + pp * 16 + lg * 4);
            const float4 sn = *(const float4*)(rope + 1024 + pp * 16 + lg * 4);
            const float ca[4] = {cs.x, cs.y, cs.z, cs.w}, sa[4] = {sn.x, sn.y, sn.z, sn.w};
#pragma unroll
            for (int i = 0; i < 4; ++i) {
              const float x0 = acc[2 * pr][mi][i], x1 = acc[2 * pr + 1][mi][i];
              acc[2 * pr][mi][i] = x0 * ca[i] - x1 * sa[i];
              acc[2 * pr + 1][mi][i] = x1 * ca[i] + x0 * sa[i];
            }
          }
        }
#pragma unroll
        for (int ni = 0; ni < 4; ++ni) {
          const int n = n0 + wn * 64 + ni * 16 + lg * 4;
          if (gcol == 58 && ni >= 2) continue;
          uint2 o2;
          o2.x = pack2(acc[ni][mi][0] * scl, acc[ni][mi][1] * scl);
          o2.y = pack2(acc[ni][mi][2] * scl, acc[ni][mi][3] * scl);
          if (gcol >= 40 && gcol < 48) *(uint2*)((bf16_t*)(p.ws + OFF_BR) + (size_t)m * 512 + (n - 2560)) = o2;
          else *(uint2*)(PB + (size_t)m * PBW + (n - delta)) = o2;
        }
      }
    }
  }
}

#undef MIX_ADVANCE
DEV void phase_gates(const Params& p, unsigned char* smem, int ntm) {
  const bf16_t* H = (const bf16_t*)(p.ws + OFF_H);
  const bf16_t* W = (const bf16_t*)(p.ws + OFF_W) + W_G;
  bf16_t* G = (bf16_t*)(p.ws + OFF_U);
  const int tid_ = otid(); const int lane = tid_ & 63, wave = tid_ >> 6, wm = wave >> 2, wn = wave & 3, lr = lane & 15, lg = lane >> 4;
  const int nslots = tile_slots(ntm, 12, 8, 4);
  int tm, tn, tm2 = 0, tn2 = 0;
  bool primed = false;
  for (int t = next_slot(blockIdx.x, nslots, ntm, 12, 8, 4, tm, tn); t < nslots;) {
    const int m0 = tm * 256, n0 = tn * 256;
    f32x4 acc[4][8];
    zero_acc<4>(acc);
    gemm_kloop<4, true>(acc, H + (size_t)m0 * D, D, W + (size_t)n0 * D, D, D, smem, primed);
    t = next_slot(t + gridDim.x, nslots, ntm, 12, 8, 4, tm2, tn2);
    primed = t < nslots;
    if (primed) glds64_prime(H + (size_t)tm2 * 256 * D, D, W + (size_t)tn2 * 256 * D, D, smem);
    tm = tm2; tn = tn2;
#pragma unroll
    for (int mi = 0; mi < 8; ++mi) {
      const int m = m0 + wm * 128 + mi * 16 + lr;
#pragma unroll
      for (int ni = 0; ni < 4; ++ni) {
        const int n = n0 + wn * 64 + ni * 16 + lg * 4;
        uint2 o2;
        o2.x = pack2(sigmoidf_(acc[ni][mi][0]), sigmoidf_(acc[ni][mi][1]));
        o2.y = pack2(sigmoidf_(acc[ni][mi][2]), sigmoidf_(acc[ni][mi][3]));
        *(uint2*)(G + (size_t)m * 3072 + n) = o2;
      }
    }
  }
}

DEV void phase_merge(const Params& p, unsigned char* smem, int ntm) {
  const bf16_t* Wb = (const bf16_t*)(p.ws + OFF_W);
  const bf16_t* O = (const bf16_t*)(p.ws + OFF_O);
  const bf16_t* G = (const bf16_t*)(p.ws + OFF_U);
  bf16_t* Y = (bf16_t*)(p.ws + OFF_Y);
  const int tid_ = otid(); const int lane = tid_ & 63, wave = tid_ >> 6, wm = wave >> 2, wn = wave & 3, lr = lane & 15, lg = lane >> 4;
  const int nslots = tile_slots(ntm, 8, 4, 8);
  for (int t = blockIdx.x; t < nslots; t += gridDim.x) {
    int tm, tn;
    if (!tile_map(t, ntm, 8, 4, 8, tm, tn)) continue;
    const int m0 = tm * 256, n0 = tn * 128;
    f32x4 y[2][8];
    zero_acc<2>(y);
#pragma unroll 1
    for (int i = 0; i < 3; ++i) {
      f32x4 acc[2][8];
      zero_acc<2>(acc);
      gemm_kloop<2, true, false>(acc, O + (size_t)m0 * 1536 + i * 512, 1536, Wb + W_BRA + (size_t)i * 524288 + (size_t)n0 * 512, 512, 512, smem);
#pragma unroll
      for (int mi = 0; mi < 8; ++mi) {
        const int m = m0 + wm * 128 + mi * 16 + lr;
#pragma unroll
        for (int ni = 0; ni < 2; ++ni) {
          const int n = n0 + wn * 32 + ni * 16 + lg * 4;
          const uint2 gq = *(const uint2*)(G + (size_t)m * 3072 + i * 1024 + n);
          y[ni][mi][0] += __uint_as_float(gq.x << 16) * acc[ni][mi][0];
          y[ni][mi][1] += __uint_as_float(gq.x & 0xffff0000u) * acc[ni][mi][1];
          y[ni][mi][2] += __uint_as_float(gq.y << 16) * acc[ni][mi][2];
          y[ni][mi][3] += __uint_as_float(gq.y & 0xffff0000u) * acc[ni][mi][3];
        }
      }
    }
#pragma unroll
    for (int mi = 0; mi < 8; ++mi) {
      const int m = m0 + wm * 128 + mi * 16 + lr;
#pragma unroll
      for (int ni = 0; ni < 2; ++ni) {
        const int n = n0 + wn * 32 + ni * 16 + lg * 4;
        uint2 o2; o2.x = pack2(y[ni][mi][0], y[ni][mi][1]); o2.y = pack2(y[ni][mi][2], y[ni][mi][3]);
        *(uint2*)(Y + (size_t)m * D + n) = o2;
      }
    }
  }
}

DEV int key_row(int b, int tp) { return tp < 64 ? b * 4096 + tp * 64 : NLAT + b * 256 + (tp - 64) * 64; }

template <int NMAP, int EF>
DEV void flash_item(unsigned char* smem, const bf16_t* __restrict__ PB, int qrow0, int qcol0, int kcol0,
                    const bf16_t* __restrict__ Vt, int b, int ra0, int ra1, int rb0, int rb1, int win_qpos0,
                    float sinkv, bool use_sink, bf16_t* __restrict__ Oout, int ocol0, float lam, float oscale,
                    const float* __restrict__ subln) {
  bf16_t* sK = (bf16_t*)smem;
  bf16_t* sV = (bf16_t*)(smem + 49152);
  const int tid = otid(), lane = tid & 63, wave = tid >> 6, lr = lane & 15, lg = lane >> 4;
  const int na = ra1 - ra0, nt = na + (rb1 - rb0);
  bf16x8 qf[NMAP][2];
  {
    const bf16_t* qp = PB + (size_t)(qrow0 + wave * 16 + lr) * PBW + qcol0 + lg * 8;
#pragma unroll
    for (int mp = 0; mp < NMAP; ++mp)
#pragma unroll
      for (int ks = 0; ks < 2; ++ks) qf[mp][ks] = *(const bf16x8*)(qp + mp * 64 + ks * 32);
  }
  f32x4 Oa[NMAP][EF];
  float mrun[NMAP], lsum[NMAP];
#pragma unroll
  for (int mp = 0; mp < NMAP; ++mp) {
    mrun[mp] = use_sink ? sinkv : -1e30f;
    lsum[mp] = 0.f;
#pragma unroll
    for (int ef = 0; ef < EF; ++ef) Oa[mp][ef] = f32x4{0.f, 0.f, 0.f, 0.f};
  }
  constexpr int NKC = NMAP, NVC = EF / 4;
  u32x4 rk[NKC], rv[NVC];
  const int crow = tid >> 3, ccol = (tid & 7) * 8;
  const int scol = ((tid & 7) ^ (crow & 7)) * 8;
#define FL_GLOAD(TI)                                                                                          \
  {                                                                                                         \
    const int tpn_ = (TI) < na ? ra0 + (TI) : rb0 + ((TI) - na);                                            \
    const bf16_t* kp_ = PB + (size_t)(key_row(b, tpn_) + crow) * PBW + kcol0 + ccol;                        \
    _Pragma("unroll") for (int mp = 0; mp < NMAP; ++mp)                                                     \
      rk[mp] = *(const u32x4*)(kp_ + mp * 64);                                                              \
    const bf16_t* vp_ = Vt + (size_t)crow * KVLEN + tpn_ * 64 + ccol;                                       \
    _Pragma("unroll") for (int i = 0; i < NVC; ++i) rv[i] = *(const u32x4*)(vp_ + (size_t)(64 * i) * KVLEN); \
  }
#define FL_SSTORE(BUF)                                                                                      \
  {                                                                                                         \
    _Pragma("unroll") for (int mp = 0; mp < NMAP; ++mp)                                                     \
      *(u32x4*)(sK + (((BUF) * 2 + mp) * 64 + crow) * 64 + scol) = rk[mp];                                  \
    _Pragma("unroll") for (int i = 0; i < NVC; ++i)                                                         \
      *(u32x4*)(sV + ((BUF) * 128 + crow + 64 * i) * 72 + ccol) = rv[i];                                    \
  }
  FL_GLOAD(0);
  FL_SSTORE(0);
  __syncthreads();
  bf16x8 pk[NMAP][2];
#pragma unroll
  for (int mp = 0; mp < NMAP; ++mp) { pk[mp][0] = bf16x8{0, 0, 0, 0, 0, 0, 0, 0}; pk[mp][1] = bf16x8{0, 0, 0, 0, 0, 0, 0, 0}; }
#define FL_PV(VBUF)                                                                                          \
  {                                                                                                         \
    _Pragma("unroll") for (int ef = 0; ef < EF; ++ef)                                                       \
      _Pragma("unroll") for (int s2 = 0; s2 < 2; ++s2) {                                                    \
        const bf16_t* vp = sV + ((VBUF) * 128 + ef * 16 + lr) * 72 + s2 * 32 + lg * 4;                      \
        const uint2 v0 = *(const uint2*)vp;                                                                 \
        const uint2 v1 = *(const uint2*)(vp + 16);                                                          \
        const u32x4 cvu = {v0.x, v0.y, v1.x, v1.y};                                                         \
        const bf16x8 cvh = __builtin_bit_cast(bf16x8, cvu);                                                 \
        _Pragma("unroll") for (int mp = 0; mp < NMAP; ++mp) Oa[mp][ef] = mfma16(cvh, pk[mp][s2], Oa[mp][ef]); \
      }                                                                                                     \
  }
  int buf = 0, pbuf = 0;
  for (int ti = 0; ti < nt; ++ti) {
    const int tp = ti < na ? ra0 + ti : rb0 + (ti - na);
    const int nbuf = buf == 2 ? 0 : buf + 1;
    if (ti + 1 < nt) FL_GLOAD(ti + 1);
    f32x4 s[NMAP][4];
#pragma unroll
    for (int mp = 0; mp < NMAP; ++mp)
#pragma unroll
      for (int kf = 0; kf < 4; ++kf) {
        s[mp][kf] = f32x4{0.f, 0.f, 0.f, 0.f};
#pragma unroll
        for (int ks = 0; ks < 2; ++ks) {
          const bf16x8 kfr = *(const bf16x8*)(sK + ((buf * 2 + mp) * 64 + kf * 16 + lr) * 64 + (((ks * 4 + lg) ^ (lr & 7)) * 8));
          s[mp][kf] = mfma16(kfr, qf[mp][ks], s[mp][kf]);
        }
      }
    FL_PV(pbuf);
    bf16x8 pkn[NMAP][2];
    float alpha[NMAP];
#pragma unroll
    for (int mp = 0; mp < NMAP; ++mp) {
      if (win_qpos0 >= 0 && tp < 64) {
        const int qpos = win_qpos0 + wave * 16 + lr;
#pragma unroll
        for (int kf = 0; kf < 4; ++kf)
#pragma unroll
          for (int r = 0; r < 4; ++r) {
            const int dd = tp * 64 + kf * 16 + lg * 4 + r - qpos;
            if (dd > 128 || dd < -128) s[mp][kf][r] = -1e30f;
          }
      }
      float mx = -1e30f;
#pragma unroll
      for (int kf = 0; kf < 4; ++kf)
#pragma unroll
        for (int r = 0; r < 4; ++r) mx = fmaxf(mx, s[mp][kf][r]);
      mx = fmaxf(mx, __shfl_xor(mx, 16));
      mx = fmaxf(mx, __shfl_xor(mx, 32));
      const float mnew = fmaxf(mrun[mp], mx);
      alpha[mp] = __builtin_amdgcn_exp2f(mrun[mp] - mnew);
      mrun[mp] = mnew;
      float ps = 0.f;
#pragma unroll
      for (int kf = 0; kf < 4; ++kf)
#pragma unroll
        for (int r = 0; r < 4; ++r) {
          const float pv = __builtin_amdgcn_exp2f(s[mp][kf][r] - mnew);
          s[mp][kf][r] = pv;
          ps += pv;
        }
      lsum[mp] = lsum[mp] * alpha[mp] + ps;
#pragma unroll
      for (int s2 = 0; s2 < 2; ++s2) {
        bf16x8 t;
#pragma unroll
        for (int r = 0; r < 4; ++r) {
          t[r] = (short)f2bf(s[mp][2 * s2][r]);
          t[4 + r] = (short)f2bf(s[mp][2 * s2 + 1][r]);
        }
        pkn[mp][s2] = t;
      }
    }
#pragma unroll
    for (int mp = 0; mp < NMAP; ++mp) {
#pragma unroll
      for (int ef = 0; ef < EF; ++ef) {
        Oa[mp][ef][0] *= alpha[mp]; Oa[mp][ef][1] *= alpha[mp]; Oa[mp][ef][2] *= alpha[mp]; Oa[mp][ef][3] *= alpha[mp];
      }
#pragma unroll
      for (int s2 = 0; s2 < 2; ++s2) pk[mp][s2] = pkn[mp][s2];
    }
    if (ti + 1 < nt) FL_SSTORE(nbuf);
    __syncthreads();
    pbuf = buf;
    buf = nbuf;
  }
  FL_PV(pbuf);
  __syncthreads();
#undef FL_PV
  float inv[NMAP];
#pragma unroll
  for (int mp = 0; mp < NMAP; ++mp) {
    float lt = lsum[mp];
    lt += __shfl_xor(lt, 16);
    lt += __shfl_xor(lt, 32);
    if (use_sink) lt += __builtin_amdgcn_exp2f(sinkv - mrun[mp]);
    inv[mp] = 1.f / lt;
  }
  bf16_t* op = Oout + (size_t)(qrow0 + wave * 16 + lr) * 1536 + ocol0 + lg * 4;
  if constexpr (NMAP == 2) {
    const float i0 = inv[0], i1 = lam * inv[1];
    float ss = 0.f;
#pragma unroll
    for (int ef = 0; ef < EF; ++ef)
#pragma unroll
      for (int r = 0; r < 4; ++r) {
        const float o = Oa[0][ef][r] * i0 - Oa[1][ef][r] * i1;
        Oa[0][ef][r] = o;
        ss += o * o;
      }
    ss += __shfl_xor(ss, 16);
    ss += __shfl_xor(ss, 32);
    const float rstd = rsqrtf(ss * (1.f / 128.f) + 1e-6f) * oscale;
#pragma unroll
    for (int ef = 0; ef < EF; ++ef) {
      const float4 g = *(const float4*)(subln + ef * 16 + lg * 4);
      uint2 o2;
      o2.x = pack2(Oa[0][ef][0] * rstd * g.x, Oa[0][ef][1] * rstd * g.y);
      o2.y = pack2(Oa[0][ef][2] * rstd * g.z, Oa[0][ef][3] * rstd * g.w);
      *(uint2*)(op + ef * 16) = o2;
    }
  } else {
#pragma unroll
    for (int ef = 0; ef < EF; ++ef) {
      uint2 o2;
      o2.x = pack2(Oa[0][ef][0] * inv[0], Oa[0][ef][1] * inv[0]);
      o2.y = pack2(Oa[0][ef][2] * inv[0], Oa[0][ef][3] * inv[0]);
      *(uint2*)(op + ef * 16) = o2;
    }
  }
}

DEV void gla_item(const Params& p, int layer, int b, int h, int dir, unsigned char* smem) {
  bf16_t* sQe = (bf16_t*)smem;
  bf16_t* sKe = (bf16_t*)(smem + 9216);
  bf16_t* sKdT = (bf16_t*)(smem + 18432);
  bf16_t* sVT = (bf16_t*)(smem + 27648);
  bf16_t* sST = (bf16_t*)(smem + 46080);
  float* sLR = (float*)(smem + 64512);
  float* sTot = (float*)(smem + 68608);
  float* sDec = (float*)(smem + 70656);
  const bf16_t* PB = (const bf16_t*)(p.ws + OFF_U);
  bf16_t* OFB = (bf16_t*)(p.ws + OFF_OFB) + (size_t)dir * MROWS * 512;
  const int tid = otid(), lane = tid & 63, wave = tid >> 6, lr = lane & 15, lg = lane >> 4;
  const int cch = tid & 63, qd = tid >> 6;
  float gwr[16];
#pragma unroll
  for (int r = 0; r < 16; ++r) gwr[r] = p.gla_gate_w[(size_t)((layer * 2 + dir) * 16 + r) * 256 + h * 64 + cch];
  const float gbv = p.gla_gate_b[(layer * 2 + dir) * 256 + h * 64 + cch];
  f32x4 st[4];
#pragma unroll
  for (int c = 0; c < 4; ++c) st[c] = f32x4{0.f, 0.f, 0.f, 0.f};
  for (int i = tid; i < 18432 / 4; i += NTHR) ((unsigned*)sST)[i] = 0u;
  __syncthreads();
  uint2 lrv;
  unsigned qraw[8], kraw[8], vraw[16];
#define GLA_PREFETCH(STEP)                                                                                  \
  {                                                                                                        \
    const int tpn_ = dir == 0 ? ((STEP) < 4 ? 64 + (STEP) : (STEP) - 4) : 67 - (STEP);                      \
    const int rb_ = key_row(b, tpn_);                                                                      \
    if (tid < 256) lrv = *(const uint2*)(PB + (size_t)(rb_ + (tid >> 2)) * PBW + PB_LR + dir * 16 + (tid & 3) * 4); \
    const bf16_t* qp_ = PB + (size_t)(rb_ + qd * 8) * PBW + PB_BQ + h * 64 + cch;                          \
    const bf16_t* kp_ = PB + (size_t)(rb_ + qd * 8) * PBW + PB_BK + h * 64 + cch;                          \
    _Pragma("unroll") for (int pi = 0; pi < 8; ++pi) { qraw[pi] = qp_[(size_t)pi * PBW]; kraw[pi] = kp_[(size_t)pi * PBW]; } \
    const bf16_t* vp_ = PB + (size_t)(rb_ + (tid >> 7) * 16) * PBW + PB_BV + h * 128 + (tid & 127);        \
    _Pragma("unroll") for (int j = 0; j < 16; ++j) vraw[j] = vp_[(size_t)j * PBW];                         \
  }
  GLA_PREFETCH(0);
  for (int step = 0; step < 68; ++step) {
    const int tp = dir == 0 ? (step < 4 ? 64 + step : step - 4) : 67 - step;
    const int rowbase = key_row(b, tp);
    {
      if (tid < 256) {
        const int pp = tid >> 2, r4 = (tid & 3) * 4;
        sLR[pp * 16 + r4 + 0] = bf2f((unsigned short)(lrv.x & 0xffff));
        sLR[pp * 16 + r4 + 1] = bf2f((unsigned short)(lrv.x >> 16));
        sLR[pp * 16 + r4 + 2] = bf2f((unsigned short)(lrv.y & 0xffff));
        sLR[pp * 16 + r4 + 3] = bf2f((unsigned short)(lrv.y >> 16));
      }
      const int e = tid & 127, ph = tid >> 7;
#pragma unroll
      for (int k8 = 0; k8 < 2; ++k8) {
        uint4 o4;
        o4.x = (unsigned)vraw[k8 * 8 + 0] | ((unsigned)vraw[k8 * 8 + 1] << 16);
        o4.y = (unsigned)vraw[k8 * 8 + 2] | ((unsigned)vraw[k8 * 8 + 3] << 16);
        o4.z = (unsigned)vraw[k8 * 8 + 4] | ((unsigned)vraw[k8 * 8 + 5] << 16);
        o4.w = (unsigned)vraw[k8 * 8 + 6] | ((unsigned)vraw[k8 * 8 + 7] << 16);
        *(uint4*)(sVT + e * 72 + ph * 16 + k8 * 8) = o4;
      }
    }
    __syncthreads();
    float cum[8];
    {
      float run = 0.f;
      if (dir == 0) {
#pragma unroll
        for (int pi = 0; pi < 8; ++pi) {
          const float* lrp = sLR + (qd * 8 + pi) * 16;
          float z = gbv;
#pragma unroll
          for (int r = 0; r < 16; ++r) z += lrp[r] * gwr[r];
          const float la = (fminf(z, 0.f) - __logf(1.f + __expf(-fabsf(z)))) * (1.f / 16.f);
          run += la;
          cum[pi] = run;
        }
      } else {
#pragma unroll
        for (int pi = 7; pi >= 0; --pi) {
          const float* lrp = sLR + (qd * 8 + pi) * 16;
          float z = gbv;
#pragma unroll
          for (int r = 0; r < 16; ++r) z += lrp[r] * gwr[r];
          const float la = (fminf(z, 0.f) - __logf(1.f + __expf(-fabsf(z)))) * (1.f / 16.f);
          run += la;
          cum[pi] = run;
        }
      }
      sTot[qd * 64 + cch] = run;
    }
    __syncthreads();
    {
      float last = 0.f, off = 0.f;
#pragma unroll
      for (int q8 = 0; q8 < 8; ++q8) {
        const float tq = sTot[q8 * 64 + cch];
        last += tq;
        if (dir == 0 ? (q8 < qd) : (q8 > qd)) off += tq;
      }
      if (qd == 0) sDec[cch] = __expf(last);
      unsigned short kdp[8];
#pragma unroll
      for (int pi = 0; pi < 8; ++pi) {
        const float cm = cum[pi] + off;
        const float qv = __uint_as_float(qraw[pi] << 16);
        const float kv = __uint_as_float(kraw[pi] << 16);
        sQe[(qd * 8 + pi) * 72 + cch] = f2bf(qv * 0.125f * __expf(cm));
        sKe[(qd * 8 + pi) * 72 + cch] = f2bf(kv * __expf(-cm));
        kdp[pi] = f2bf(kv * __expf(last - cm));
      }
      uint4 o4;
      o4.x = (unsigned)kdp[0] | ((unsigned)kdp[1] << 16);
      o4.y = (unsigned)kdp[2] | ((unsigned)kdp[3] << 16);
      o4.z = (unsigned)kdp[4] | ((unsigned)kdp[5] << 16);
      o4.w = (unsigned)kdp[6] | ((unsigned)kdp[7] << 16);
      *(uint4*)(sKdT + cch * 72 + qd * 8) = o4;
    }
    if (step + 1 < 68) GLA_PREFETCH(step + 1);
    __syncthreads();
#pragma unroll
    for (int iq = 0; iq < 4; ++iq) {
      bf16x8 qfr[2];
#pragma unroll
      for (int ks = 0; ks < 2; ++ks) qfr[ks] = *(const bf16x8*)(sQe + (iq * 16 + lr) * 72 + ks * 32 + lg * 8);
      bf16x8 ap[2];
      bool live[2];
#pragma unroll
      for (int s2 = 0; s2 < 2; ++s2) {
        f32x4 at[2];
        live[s2] = dir == 0 ? (2 * s2 <= iq) : (2 * s2 + 1 >= iq);
#pragma unroll
        for (int jj = 0; jj < 2; ++jj) {
          const int jf = 2 * s2 + jj;
          at[jj] = f32x4{0.f, 0.f, 0.f, 0.f};
          const bool tile_live = dir == 0 ? (jf <= iq) : (jf >= iq);
          if (tile_live) {
#pragma unroll
            for (int ks = 0; ks < 2; ++ks) {
              const bf16x8 kfr = *(const bf16x8*)(sKe + (jf * 16 + lr) * 72 + ks * 32 + lg * 8);
              at[jj] = mfma16(kfr, qfr[ks], at[jj]);
            }
            if (jf == iq) {
              const int ipos = lr;
#pragma unroll
              for (int r = 0; r < 4; ++r) {
                const int jpos = lg * 4 + r;
                const bool keep = dir == 0 ? (ipos >= jpos) : (ipos <= jpos);
                if (!keep) at[jj][r] = 0.f;
              }
            }
          }
        }
        bf16x8 t;
#pragma unroll
        for (int r = 0; r < 4; ++r) { t[r] = (short)f2bf(at[0][r]); t[4 + r] = (short)f2bf(at[1][r]); }
        ap[s2] = t;
      }
      {
        const int erow = wave * 16 + lr;
        f32x4 o = f32x4{0.f, 0.f, 0.f, 0.f};
#pragma unroll
        for (int s2 = 0; s2 < 2; ++s2) {
          if (live[s2]) {
            const bf16_t* vp = sVT + erow * 72 + s2 * 32 + lg * 4;
            const uint2 v0 = *(const uint2*)vp;
            const uint2 v1 = *(const uint2*)(vp + 16);
            const u32x4 cvu = {v0.x, v0.y, v1.x, v1.y};
            o = mfma16(__builtin_bit_cast(bf16x8, cvu), ap[s2], o);
          }
        }
#pragma unroll
        for (int ks = 0; ks < 2; ++ks) {
          const bf16x8 sfr = *(const bf16x8*)(sST + erow * 72 + ks * 32 + lg * 8);
          o = mfma16(sfr, qfr[ks], o);
        }
        uint2 o2; o2.x = pack2(o[0], o[1]); o2.y = pack2(o[2], o[3]);
        *(uint2*)(OFB + (size_t)(rowbase + iq * 16 + lr) * 512 + h * 128 + wave * 16 + lg * 4) = o2;
      }
    }
    {
      const int erow = wave * 16 + lr;
      bf16x8 vfr[2];
#pragma unroll
      for (int ps = 0; ps < 2; ++ps) vfr[ps] = *(const bf16x8*)(sVT + erow * 72 + ps * 32 + lg * 8);
#pragma unroll
      for (int cf = 0; cf < 4; ++cf) {
        const float dc = sDec[cf * 16 + lr];
        f32x4 a = st[cf];
        a[0] *= dc; a[1] *= dc; a[2] *= dc; a[3] *= dc;
#pragma unroll
        for (int ps = 0; ps < 2; ++ps) {
          const bf16x8 kdf = *(const bf16x8*)(sKdT + (cf * 16 + lr) * 72 + ps * 32 + lg * 8);
          a = mfma16(vfr[ps], kdf, a);
        }
        st[cf] = a;
      }
    }
#pragma unroll
    for (int cf = 0; cf < 4; ++cf)
#pragma unroll
      for (int r = 0; r < 4; ++r)
        sST[(wave * 16 + lg * 4 + r) * 72 + cf * 16 + lr] = f2bf(st[cf][r]);
    __syncthreads();
  }
}

#undef GLA_PREFETCH

DEV void phase_mixers(const Params& p, int layer, unsigned char* smem) {
  volatile int* s_itemp = (volatile int*)(smem + LDS_MISC);
  const bf16_t* PB = (const bf16_t*)(p.ws + OFF_U);
  const bf16_t* VtA = (const bf16_t*)(p.ws + OFF_VTA);
  const bf16_t* VtC = (const bf16_t*)(p.ws + OFF_VTC);
  bf16_t* O = (bf16_t*)(p.ws + OFF_O);
  int* ctr = (int*)(p.ws + OFF_MISC + 64) + layer;
  const float lam = ((const float*)(p.ws + OFF_MISC))[layer];
  const float lam_init = 0.8f - 0.6f * expf(-0.3f * (float)layer);
  const int total = 64 + 1024 + 64 + 2048 + 128;
  for (;;) {
    if (otid() == 0) *s_itemp = atomicAdd(ctr, 1);
    __syncthreads();
    int idx = __builtin_amdgcn_readfirstlane(*s_itemp);
    __syncthreads();
    if (idx >= total) break;
    if (idx < 64) {
      gla_item(p, layer, idx >> 3, (idx >> 1) & 3, idx & 1, smem);
      continue;
    }
    idx -= 64;
    if (idx < 1024 + 64) {
      int b, h, qrow0, r0;
      if (idx < 1024) { b = idx >> 7; h = (idx >> 5) & 3; qrow0 = b * 4096 + (idx & 31) * 128; r0 = 0; }
      else { const int j = idx - 1024; b = j >> 3; h = (j >> 1) & 3; qrow0 = NLAT + b * 256 + (j & 1) * 128; r0 = 64; }
      flash_item<2, 8>(smem, PB, qrow0, PB_AQ + h * 128, PB_AK + h * 128, VtA + (size_t)((b * 4 + h) * 128) * KVLEN, b,
                       r0, 68, 0, 0, -1, 0.f, false, O, h * 128, lam, 1.f - lam_init, p.diff_subln + layer * 128);
      continue;
    }
    idx -= 1024 + 64;
    {
      int b, hq, qrow0, lo, hi, r0, r1, win;
      if (idx < 2048) {
        b = idx >> 8; hq = (idx >> 5) & 7; const int qt = idx & 31;
        qrow0 = b * 4096 + qt * 128; lo = 2 * qt - 2 < 0 ? 0 : 2 * qt - 2; hi = 2 * qt + 4 > 64 ? 64 : 2 * qt + 4; r0 = 64; r1 = 68; win = qt * 128;
      } else {
        const int j = idx - 2048; b = j >> 4; hq = (j >> 1) & 7;
        qrow0 = NLAT + b * 256 + (j & 1) * 128; lo = 64; hi = 68; r0 = 0; r1 = 0; win = -1;
      }
      const int kvh = hq >> 2;
      flash_item<1, 4>(smem, PB, qrow0, PB_CQ + hq * 64, PB_CK + kvh * 64, VtC + (size_t)((b * 2 + kvh) * 64) * KVLEN, b,
                       lo, hi, r0, r1, win, p.swa_sink[layer * 8 + hq] * 1.44269504089f, true, O, 1024 + hq * 64, 0.f, 1.f, nullptr);
    }
  }
}

DEV void phase_gla_final(const Params& p, int layer) {
  const int tid = otid(), lane = tid & 63, wave = tid >> 6;
  const bf16_t* PB = (const bf16_t*)(p.ws + OFF_U);
  const bf16_t* OF = (const bf16_t*)(p.ws + OFF_OFB);
  const bf16_t* OB = OF + (size_t)MROWS * 512;
  bf16_t* O = (bf16_t*)(p.ws + OFF_O);
  const float* gn = p.gla_norm + layer * 128;
  const int nitems = MROWS / 32;
  for (int it = blockIdx.x; it < nitems; it += gridDim.x) {
    for (int rr = 0; rr < 4; ++rr) {
      const int m = it * 32 + wave * 4 + rr;
      const uint4 a = *(const uint4*)(OF + (size_t)m * 512 + lane * 8);
      const uint4 bq = *(const uint4*)(OB + (size_t)m * 512 + lane * 8);
      const uint4 rq = *(const uint4*)((const bf16_t*)(p.ws + OFF_BR) + (size_t)m * 512 + lane * 8);
      const unsigned aw[4] = {a.x, a.y, a.z, a.w}, bw[4] = {bq.x, bq.y, bq.z, bq.w}, rw[4] = {rq.x, rq.y, rq.z, rq.w};
      float o[8], rv[8];
      float ss = 0.f;
#pragma unroll
      for (int i = 0; i < 4; ++i) {
        o[2 * i] = bf2f((unsigned short)(aw[i] & 0xffff)) + bf2f((unsigned short)(bw[i] & 0xffff));
        o[2 * i + 1] = bf2f((unsigned short)(aw[i] >> 16)) + bf2f((unsigned short)(bw[i] >> 16));
        rv[2 * i] = bf2f((unsigned short)(rw[i] & 0xffff));
        rv[2 * i + 1] = bf2f((unsigned short)(rw[i] >> 16));
        ss += o[2 * i] * o[2 * i] + o[2 * i + 1] * o[2 * i + 1];
      }
      ss += __shfl_xor(ss, 1); ss += __shfl_xor(ss, 2); ss += __shfl_xor(ss, 4); ss += __shfl_xor(ss, 8);
      const float rstd = rsqrtf(ss * (1.f / 128.f) + 1e-6f);
      const int e0 = (lane & 15) * 8;
      float res[8];
#pragma unroll
      for (int i = 0; i < 8; ++i) res[i] = o[i] * rstd * gn[e0 + i] * siluf_(rv[i]);
      uint4 o4;
      o4.x = pack2(res[0], res[1]); o4.y = pack2(res[2], res[3]); o4.z = pack2(res[4], res[5]); o4.w = pack2(res[6], res[7]);
      *(uint4*)(O + (size_t)m * 1536 + 512 + lane * 8) = o4;
    }
  }
}

DEV void phase_final(const Params& p) {
  const int tid = otid(), lane = tid & 63, wave = tid >> 6;
  const int nitems = NLAT / 32;
  for (int it = blockIdx.x; it < nitems; it += gridDim.x) {
    for (int rr = 0; rr < 4; ++rr) {
      const int m = it * 32 + wave * 4 + rr;
      float* xr = p.out + (size_t)m * D;
      float4 v[4];
      float ss = 0.f;
#pragma unroll
      for (int q = 0; q < 4; ++q) {
        v[q] = *(const float4*)(xr + q * 256 + lane * 4);
        ss += v[q].x * v[q].x + v[q].y * v[q].y + v[q].z * v[q].z + v[q].w * v[q].w;
      }
#pragma unroll
      for (int o = 32; o >= 1; o >>= 1) ss += __shfl_xor(ss, o);
      const float rstd = rsqrtf(ss * (1.f / 1024.f) + 1e-6f);
#pragma unroll
      for (int q = 0; q < 4; ++q) {
        const float4 g = *(const float4*)(p.final_g + q * 256 + lane * 4);
        float4 o4;
        o4.x = v[q].x * rstd * g.x; o4.y = v[q].y * rstd * g.y; o4.z = v[q].z * rstd * g.z; o4.w = v[q].w * rstd * g.w;
        *(float4*)(xr + q * 256 + lane * 4) = o4;
      }
    }
  }
}


#define XB_TMO      128
#define XB_XCNT(j)  (256  + 64 * (j))
#define XB_XSUB(j)  (1280 + 64 * (j))
#define XB_XGEN(j)  (2304 + 64 * (j))
#define XB_TOP      3328
#define XB_TOPGEN   3392
#define XCD_BAR_WORDS 3456
#define XB_SPIN_CAP (1u << 22)
#define LAS __attribute__((address_space(3)))
DEV unsigned xb_ld(unsigned* p) { return __hip_atomic_load(p, __ATOMIC_RELAXED, __HIP_MEMORY_SCOPE_AGENT); }
DEV unsigned xb_add(unsigned* p, unsigned v) { return __hip_atomic_fetch_add(p, v, __ATOMIC_RELAXED, __HIP_MEMORY_SCOPE_AGENT); }
DEV unsigned xb_xcc_id() { return (unsigned)__builtin_amdgcn_s_getreg((3 << 11) | 20) & 0xFu; }
#define XB_SPIN(cond, bar) do { unsigned _sp = 0; while (cond) { __builtin_amdgcn_s_sleep(1); \
    if ((++_sp & 255u) == 0u) { if (xb_ld(&(bar)[XB_TMO])) break; if (_sp > XB_SPIN_CAP) { atomicAdd(&(bar)[XB_TMO], 1u); break; } } } } while (0)
struct XcdBarrier { unsigned* bar; unsigned x; volatile LAS unsigned* st; };
DEV XcdBarrier xcd_barrier_post(unsigned* bar, volatile LAS unsigned* st) {
  XcdBarrier b; b.bar = bar; b.x = xb_xcc_id(); b.st = st;
  if (threadIdx.x == 0) (void)xb_add(&bar[XB_XCNT(b.x)], 1u);
  return b;
}
DEV void xcd_barrier_complete(unsigned* bar, unsigned x, unsigned& nloc, unsigned& nx) {
  const unsigned G = gridDim.x * gridDim.y * gridDim.z;
  unsigned sum, cnt, mine, sp = 0u;
  for (;;) {
    sum = 0u; cnt = 0u; mine = 0u;
#pragma unroll
    for (unsigned j = 0; j < 16; ++j) { const unsigned c = xb_ld(&bar[XB_XCNT(j)]); sum += c; cnt += (c > 0u) ? 1u : 0u; mine = (j == x) ? c : mine; }
    if (sum == G) break;
    __builtin_amdgcn_s_sleep(1);
    if ((++sp & 255u) == 0u) { if (xb_ld(&bar[XB_TMO])) break; if (sp > XB_SPIN_CAP) { atomicAdd(&bar[XB_TMO], 1u); break; } }
  }
  nloc = mine > 0u ? mine : 1u; nx = cnt > 0u ? cnt : 1u;
}
DEV void xcd_barrier(const XcdBarrier& b) {
  asm volatile("s_waitcnt vmcnt(0)" ::: "memory");
  __syncthreads();
  if (threadIdx.x == 0) {
    unsigned* bar = b.bar;
    __builtin_amdgcn_s_waitcnt(0);
    unsigned nloc = b.st[0], nx = b.st[1];
    if (nloc == 0u) { xcd_barrier_complete(bar, b.x, nloc, nx); b.st[0] = nloc; b.st[1] = nx; }
    const unsigned old = xb_add(&bar[XB_XSUB(b.x)], 1u);
    const unsigned gen = old / nloc;
    if (old + 1u == (gen + 1u) * nloc) {
      __builtin_amdgcn_fence(__ATOMIC_RELEASE, "agent");
      asm volatile("s_waitcnt vmcnt(0)" ::: "memory");
      const unsigned og = xb_add(&bar[XB_TOP], 1u);
      const unsigned tg = og / nx;
      if (og + 1u == (tg + 1u) * nx) xb_add(&bar[XB_TOPGEN], 1u);
      else XB_SPIN(xb_ld(&bar[XB_TOPGEN]) == tg, bar);
      __builtin_amdgcn_fence(__ATOMIC_ACQUIRE, "agent");
      xb_add(&bar[XB_XGEN(b.x)], 1u);
      asm volatile("s_waitcnt vmcnt(0)" ::: "memory");
    } else {
      XB_SPIN(xb_ld(&bar[XB_XGEN(b.x)]) == gen, bar);
      __builtin_amdgcn_fence(__ATOMIC_ACQUIRE, "agent");
      asm volatile("s_waitcnt vmcnt(0)" ::: "memory");
    }
  }
  __syncthreads();
}

__global__ void __launch_bounds__(512, 2) mega(Params p) {
  extern __shared__ __attribute__((aligned(16))) unsigned char smem[];
  cg::grid_group grid = cg::this_grid();
  volatile LAS unsigned* xst = (volatile LAS unsigned*)(smem + LDS_MISC + 16);
  if (threadIdx.x == 0) { xst[0] = 0u; xst[1] = 0u; }
  __syncthreads();
  XcdBarrier xb = xcd_barrier_post((unsigned*)(p.ws + OFF_BAR), xst);
  if (p.ph_lo < 0) grid.sync();
  for (int ph = p.ph_lo; ph < p.ph_hi; ++ph) {
    if (ph == 0) {
      phase_prologue(p, smem);
    } else if (ph == NPH - 1) {
      phase_final(p);
    } else {
      const int layer = (ph - 1) / NSUB, sub = (ph - 1) % NSUB;
      const bf16_t* H = (const bf16_t*)(p.ws + OFF_H);
      const bf16_t* U = (const bf16_t*)(p.ws + OFF_U);
      const bf16_t* Yb = (const bf16_t*)(p.ws + OFF_Y);
      const bool last = layer == DEPTH - 1;
      const int ntm_post = last ? 128 : 136;
      switch (sub) {
        case 0: phase_norm(p, layer, 0, true, smem, MROWS); break;
        case 1: phase_ffn_up(p, W_UP1, smem, 136); break;
        case 2: phase_gemm_resid(p, U, FF, FF, W_DN1, layer, 2, 0.5f, smem, true); break;
        case 3: phase_norm(p, layer, 1, false, smem, MROWS); break;
        case 4: phase_mix(p, smem); break;
        case 5: phase_mixers(p, layer, smem); break;
        case 6: phase_gates(p, smem, ntm_post); phase_gla_final(p, layer); break;
        case 7: phase_merge(p, smem, ntm_post); break;
        case 8: phase_gemm_resid(p, Yb, D, D, W_OUT, layer, 5, 1.0f, smem, !last); break;
        case 9: phase_norm(p, layer, 2, false, smem, last ? NLAT : MROWS); break;
        case 10: phase_ffn_up(p, W_UP2, smem, ntm_post); break;
        default: phase_gemm_resid(p, U, FF, FF, W_DN2, layer, 8, 0.5f, smem, !last); break;
      }
      (void)H;
    }
    if (ph + 1 < p.ph_hi) xcd_barrier(xb);
  }
}

extern "C" void kernel_launch(void* const* d_in, const int* in_sizes, int n_in, void* d_out, int out_size, void* d_ws,
                              size_t ws_size, hipStream_t stream) {
  static int grid_blocks = 0;
  if (!grid_blocks) {
    if (ws_size < WS_NEED) fprintf(stderr, "kernel_launch: workspace too small: %zu < %zu\n", ws_size, (size_t)WS_NEED);
    hipFuncSetAttribute((const void*)mega, hipFuncAttributeMaxDynamicSharedMemorySize, LDS_BYTES);
    int dev = 0, cus = 0, per_cu = 0;
    hipGetDevice(&dev);
    hipDeviceGetAttribute(&cus, hipDeviceAttributeMultiprocessorCount, dev);
    hipOccupancyMaxActiveBlocksPerMultiprocessor(&per_cu, (const void*)mega, NTHR, LDS_BYTES);
    if (per_cu > 1) per_cu = 1;
    if (per_cu < 1) per_cu = 1;
    grid_blocks = cus * per_cu;
  }
  Params p{};
  const float** pp = (const float**)&p;
  for (int i = 0; i < 23; ++i) pp[i] = (const float*)d_in[i];
  p.out = (float*)d_out;
  p.ws = (unsigned char*)d_ws;
  p.ph_lo = 0;
  p.ph_hi = NPH;
  void* args[] = {&p};
  (void)hipMemsetAsync((unsigned char*)d_ws + OFF_BAR, 0, 3456 * 4, stream);
  (void)hipMemsetAsync((unsigned char*)d_ws + OFF_MOD, 0, (size_t)DEPTH * 9 * 9216 * 4, stream);
  hipError_t e = hipLaunchCooperativeKernel((const void*)mega, dim3(grid_blocks), dim3(NTHR), args, LDS_BYTES, stream);
  if (e != hipSuccess) fprintf(stderr, "cooperative launch failed: %s (grid %d)\n", hipGetErrorString(e), grid_blocks);
}
```

```cpp
#include <hip/hip_runtime.h>
#include <hip/hip_cooperative_groups.h>
#include <cstdio>
namespace cg = cooperative_groups;

typedef unsigned short bf16_t;
using bf16x8 = __attribute__((ext_vector_type(8))) short;
using f32x4  = __attribute__((ext_vector_type(4))) float;
using u32x4  = __attribute__((ext_vector_type(4))) unsigned;

#define DEV __device__ __forceinline__

constexpr int D = 1024, FF = 2816, NLAT = 32768, NCTX = 2048, MROWS = 34816, DEPTH = 4;
constexpr int PBW = 3232;
constexpr int PB_AQ = 0, PB_AK = 512, PB_BQ = 1024, PB_BK = 1280, PB_BV = 1536, PB_BR = 2048, PB_CQ = 2560, PB_CK = 3072, PB_LR = 3200;
constexpr int KVLEN = 4352;
constexpr int LDS_BYTES = 143360 + 64;
constexpr int LDS_MISC = 143360;
constexpr int NTHR = 512;
constexpr int NSUB = 12;
constexpr int NPH = 1 + NSUB * DEPTH + 1;

constexpr size_t OFF_XC   = 0;
constexpr size_t OFF_H    = OFF_XC + (size_t)NCTX * D * 4;
constexpr size_t OFF_U    = OFF_H + (size_t)MROWS * D * 2;
constexpr size_t OFF_W    = OFF_U + (size_t)MROWS * PBW * 2;
constexpr size_t W_ELEMS  = 27262976;
constexpr size_t OFF_VTA  = OFF_W + W_ELEMS * 2;
constexpr size_t OFF_VTC  = OFF_VTA + (size_t)8 * 4 * 128 * KVLEN * 2;
constexpr size_t OFF_O    = OFF_VTC + (size_t)8 * 2 * 64 * KVLEN * 2;
constexpr size_t OFF_OFB  = OFF_O + (size_t)MROWS * 1536 * 2;
constexpr size_t OFF_MOD  = OFF_OFB + (size_t)2 * MROWS * 512 * 2;
constexpr size_t OFF_ROPE = OFF_MOD + (size_t)DEPTH * 9 * 9216 * 4;
constexpr size_t OFF_MISC = OFF_ROPE + 8192;
constexpr size_t OFF_BAR  = OFF_MISC + 256;
constexpr size_t OFF_Y    = OFF_BAR + 16384;
constexpr size_t OFF_BR   = OFF_Y + (size_t)MROWS * D * 2;
constexpr size_t WS_NEED  = OFF_BR + (size_t)MROWS * 512 * 2;

constexpr size_t W_UP1 = 0, W_DN1 = 5767168, W_UP2 = 8650752, W_DN2 = 14417920, W_MIX = 17301504,
                 W_G = 21495808, W_BRA = 24641536, W_BRB = 25165824, W_BRC = 25690112, W_OUT = 26214400;

struct Params {
  const float *x, *c, *ctx, *c_ctx, *w_ada, *b_ada, *norm_g, *w_ffn1_in, *w_ffn1_out, *w_ffn2_in, *w_ffn2_out,
              *w_mix_in, *diff_lambda, *diff_subln, *gla_gate_w, *gla_gate_b, *gla_norm, *swa_sink,
              *w_br_a, *w_br_b, *w_br_c, *w_mix_out, *final_g;
  float* out;
  unsigned char* ws;
  int ph_lo, ph_hi;
};

DEV int otid() { int t = threadIdx.x; asm volatile("" : "+v"(t)); return t; }
typedef __bf16 hbf16x2_t __attribute__((ext_vector_type(2)));
typedef float hf32x2_t __attribute__((ext_vector_type(2)));
DEV unsigned short f2bf(float f) { const __bf16 h = (__bf16)f; return __builtin_bit_cast(unsigned short, h); }
DEV float bf2f(unsigned short b) { return __uint_as_float(((unsigned)b) << 16); }
DEV unsigned pack2(float a, float b) { const hf32x2_t v = {a, b}; return __builtin_bit_cast(unsigned, __builtin_convertvector(v, hbf16x2_t)); }
DEV float sigmoidf_(float x) { return __builtin_amdgcn_rcpf(1.f + __expf(-x)); }
DEV float siluf_(float x) { return x * __builtin_amdgcn_rcpf(1.f + __expf(-x)); }
DEV f32x4 mfma16(bf16x8 a, bf16x8 b, f32x4 c) { return __builtin_amdgcn_mfma_f32_16x16x32_bf16(a, b, c, 0, 0, 0); }
DEV int mod_bp(int m) { return m < NLAT ? (m >> 12) : 8; }
DEV float* xrow_ptr(const Params& p, int m) {
  return m < NLAT ? p.out + (size_t)m * D : (float*)(p.ws + OFF_XC) + (size_t)(m - NLAT) * D;
}

template <int NI, bool TRANS>
DEV void gemm_compute(f32x4 (&acc)[NI][8], const bf16_t* pa, const bf16_t* pb, int lr, int lg) {
#pragma unroll
  for (int ks = 0; ks < 2; ++ks) {
    bf16x8 bfr[NI];
    const int so = ((ks * 4 + lg) ^ (lr & 7)) * 8;
#pragma unroll
    for (int ni = 0; ni < NI; ++ni) bfr[ni] = *(const bf16x8*)(pb + ni * 16 * 64 + so);
#pragma unroll
    for (int mh = 0; mh < 2; ++mh) {
      bf16x8 af[4];
#pragma unroll
      for (int mi = 0; mi < 4; ++mi) af[mi] = *(const bf16x8*)(pa + (mh * 4 + mi) * 16 * 64 + so);
#pragma unroll
      for (int ni = 0; ni < NI; ++ni)
#pragma unroll
        for (int mi = 0; mi < 4; ++mi)
          acc[ni][mh * 4 + mi] = TRANS ? mfma16(bfr[ni], af[mi], acc[ni][mh * 4 + mi]) : mfma16(af[mi], bfr[ni], acc[ni][mh * 4 + mi]);
    }
  }
}

#define GL_LAS __attribute__((address_space(3)))
#define GL_BARRIER() do { asm volatile("s_waitcnt lgkmcnt(0)" ::: "memory"); __builtin_amdgcn_s_barrier(); asm volatile("" ::: "memory"); } while (0)
template <bool TRANS>
DEV void gemm_kloop_glds4(f32x4 (&acc)[4][8], const bf16_t* __restrict__ Ag, int lda, const bf16_t* __restrict__ Bg, int ldb,
                          int K, unsigned char* smem) {
  const int tid = otid(), lane = tid & 63, wave = tid >> 6, wm = wave >> 2, wn = wave & 3;
  const int lr = lane & 15, lg = lane >> 4;
  const int KT2 = K >> 5;
  const int grow = lane >> 2, gpos = lane & 3;
  const int gsw = (0x78 >> (((grow >> 2) & 3) * 2)) & 3;
  const bf16_t* asrc = Ag + (size_t)(wave * 16 + grow) * lda + ((gpos ^ gsw) * 8);
  const bf16_t* bsrc = Bg + (size_t)(wave * 16 + grow) * ldb + ((gpos ^ gsw) * 8);
  unsigned char* ldsw = smem + wave * 1024;
#define GL_TILE(J)                                                                                          \
  {                                                                                                        \
    const int st_ = (J) & 3, k0_ = (J) << 5;                                                               \
    _Pragma("unroll") for (int i = 0; i < 2; ++i) {                                                        \
      __builtin_amdgcn_global_load_lds((const unsigned*)(asrc + (size_t)(i * 128) * lda + k0_),            \
                                       (GL_LAS unsigned*)(ldsw + st_ * 32768 + i * 8192), 16, 0, 0);       \
      __builtin_amdgcn_global_load_lds((const unsigned*)(bsrc + (size_t)(i * 128) * ldb + k0_),            \
                                       (GL_LAS unsigned*)(ldsw + st_ * 32768 + 16384 + i * 8192), 16, 0, 0); \
    }                                                                                                      \
  }
  const int rsw = (0x78 >> (((lr >> 2) & 3) * 2)) & 3;
  const bf16_t* pa = (const bf16_t*)smem + (wm * 128 + lr) * 32 + ((lg ^ rsw) * 8);
  const bf16_t* pb = (const bf16_t*)(smem + 16384) + (wn * 64 + lr) * 32 + ((lg ^ rsw) * 8);
  GL_TILE(0);
  GL_TILE(1);
  GL_TILE(2);
  for (int j = 0; j < KT2; ++j) {
    if (j + 2 < KT2) asm volatile("s_waitcnt vmcnt(8)" ::: "memory");
    else if (j + 1 < KT2) asm volatile("s_waitcnt vmcnt(4)" ::: "memory");
    else asm volatile("s_waitcnt vmcnt(0)" ::: "memory");
    GL_BARRIER();
    if (j + 3 < KT2) GL_TILE(j + 3);
    const bf16_t* qa = pa + (j & 3) * 16384;
    const bf16_t* qb = pb + (j & 3) * 16384;
    bf16x8 bfr[4];
#pragma unroll
    for (int ni = 0; ni < 4; ++ni) bfr[ni] = *(const bf16x8*)(qb + ni * 16 * 32);
#pragma unroll
    for (int mh = 0; mh < 2; ++mh) {
      bf16x8 af[4];
#pragma unroll
      for (int mi = 0; mi < 4; ++mi) af[mi] = *(const bf16x8*)(qa + (mh * 4 + mi) * 16 * 32);
#pragma unroll
      for (int ni = 0; ni < 4; ++ni)
#pragma unroll
        for (int mi = 0; mi < 4; ++mi)
          acc[ni][mh * 4 + mi] = TRANS ? mfma16(bfr[ni], af[mi], acc[ni][mh * 4 + mi]) : mfma16(af[mi], bfr[ni], acc[ni][mh * 4 + mi]);
    }
  }
  GL_BARRIER();
#undef GL_TILE
}

template <bool TRANS>
DEV void gemm_kloop_glds64(f32x4 (&acc)[4][8], const bf16_t* __restrict__ Ag, int lda, const bf16_t* __restrict__ Bg, int ldb,
                           int K, unsigned char* smem, bool primed) {
  const int tid = otid(), lane = tid & 63, wave = tid >> 6, wm = wave >> 2, wn = wave & 3;
  const int lr = lane & 15, lg = lane >> 4;
  const int KT = K >> 6;
  const int grow = lane >> 3, gpos = lane & 7;
  const bf16_t* asrc = Ag + (size_t)(wave * 8 + grow) * lda + ((gpos ^ grow) * 8);
  const bf16_t* bsrc = Bg + (size_t)(wave * 8 + grow) * ldb + ((gpos ^ grow) * 8);
  unsigned char* ldsw = smem + wave * 1024;
#define GL64_TILE(J)                                                                                        \
  {                                                                                                        \
    const int st_ = (J) & 1, k0_ = (J) << 6;                                                               \
    _Pragma("unroll") for (int i = 0; i < 4; ++i) {                                                        \
      __builtin_amdgcn_global_load_lds((const unsigned*)(asrc + (size_t)(i * 64) * lda + k0_),             \
                                       (GL_LAS unsigned*)(ldsw + st_ * 65536 + i * 8192), 16, 0, 0);       \
      __builtin_amdgcn_global_load_lds((const unsigned*)(bsrc + (size_t)(i * 64) * ldb + k0_),             \
                                       (GL_LAS unsigned*)(ldsw + st_ * 65536 + 32768 + i * 8192), 16, 0, 0); \
    }                                                                                                      \
  }
  const bf16_t* pa = (const bf16_t*)smem + (wm * 128 + lr) * 64;
  const bf16_t* pb = (const bf16_t*)(smem + 32768) + (wn * 64 + lr) * 64;
  if (!primed) GL64_TILE(0);
  for (int j = 0; j < KT; ++j) {
    asm volatile("s_waitcnt vmcnt(0)" ::: "memory");
    GL_BARRIER();
    const bf16_t* qa = pa + (j & 1) * 32768;
    const bf16_t* qb = pb + (j & 1) * 32768;
    bf16x8 bf0[4], af0[8], bf1[4], af1[4];
    const int so0 = (lg ^ (lr & 7)) * 8, so1 = ((4 + lg) ^ (lr & 7)) * 8;
#pragma unroll
    for (int ni = 0; ni < 4; ++ni) bf0[ni] = *(const bf16x8*)(qb + ni * 16 * 64 + so0);
#pragma unroll
    for (int mi = 0; mi < 8; ++mi) af0[mi] = *(const bf16x8*)(qa + mi * 16 * 64 + so0);
    __builtin_amdgcn_sched_barrier(0);
    if (j + 1 < KT) GL64_TILE(j + 1);
    __builtin_amdgcn_sched_barrier(0);
#pragma unroll
    for (int ni = 0; ni < 4; ++ni) bf1[ni] = *(const bf16x8*)(qb + ni * 16 * 64 + so1);
#pragma unroll
    for (int mi = 0; mi < 4; ++mi) af1[mi] = *(const bf16x8*)(qa + mi * 16 * 64 + so1);
    __builtin_amdgcn_sched_barrier(0);
#pragma unroll
    for (int mi = 0; mi < 8; ++mi)
#pragma unroll
      for (int ni = 0; ni < 4; ++ni)
        acc[ni][mi] = TRANS ? mfma16(bf0[ni], af0[mi], acc[ni][mi]) : mfma16(af0[mi], bf0[ni], acc[ni][mi]);
    bf16x8 af2[4];
#pragma unroll
    for (int mi = 0; mi < 4; ++mi) af2[mi] = *(const bf16x8*)(qa + (4 + mi) * 16 * 64 + so1);
#pragma unroll
    for (int mi = 0; mi < 4; ++mi)
#pragma unroll
      for (int ni = 0; ni < 4; ++ni)
        acc[ni][mi] = TRANS ? mfma16(bf1[ni], af1[mi], acc[ni][mi]) : mfma16(af1[mi], bf1[ni], acc[ni][mi]);
#pragma unroll
    for (int mi = 0; mi < 4; ++mi)
#pragma unroll
      for (int ni = 0; ni < 4; ++ni)
        acc[ni][4 + mi] = TRANS ? mfma16(bf1[ni], af2[mi], acc[ni][4 + mi]) : mfma16(af2[mi], bf1[ni], acc[ni][4 + mi]);
  }
  GL_BARRIER();
#undef GL64_TILE
}

DEV void glds64_prime(const bf16_t* __restrict__ Ag, int lda, const bf16_t* __restrict__ Bg, int ldb, unsigned char* smem) {
  const int tid = otid(), lane = tid & 63, wave = tid >> 6;
  const int grow = lane >> 3, gpos = lane & 7;
  const bf16_t* asrc = Ag + (size_t)(wave * 8 + grow) * lda + ((gpos ^ grow) * 8);
  const bf16_t* bsrc = Bg + (size_t)(wave * 8 + grow) * ldb + ((gpos ^ grow) * 8);
  unsigned char* ldsw = smem + wave * 1024;
#pragma unroll
  for (int i = 0; i < 4; ++i) {
    __builtin_amdgcn_global_load_lds((const unsigned*)(asrc + (size_t)(i * 64) * lda), (GL_LAS unsigned*)(ldsw + i * 8192), 16, 0, 0);
    __builtin_amdgcn_global_load_lds((const unsigned*)(bsrc + (size_t)(i * 64) * ldb), (GL_LAS unsigned*)(ldsw + 32768 + i * 8192), 16, 0, 0);
  }
}

template <int NI, bool TRANS, bool DEEP = (NI == 2)>
DEV void gemm_kloop(f32x4 (&acc)[NI][8], const bf16_t* __restrict__ Ag, int lda, const bf16_t* __restrict__ Bg, int ldb,
                    int K, unsigned char* smem, bool primed = false) {
  if constexpr (NI == 4) { gemm_kloop_glds64<TRANS>(acc, Ag, lda, Bg, ldb, K, smem, primed); return; }
  bf16_t* sA = (bf16_t*)smem;
  bf16_t* sB = (bf16_t*)(smem + 32768);
  const int tid = otid(), lane = tid & 63, wave = tid >> 6, wm = wave >> 2, wn = wave & 3;
  const int lr = lane & 15, lg = lane >> 4;
  const int crow = tid >> 3, ccol = (tid & 7) * 8;
  const int scol = ((tid & 7) ^ (crow & 7)) * 8;
  const bf16_t* ap = Ag + (size_t)crow * lda + ccol;
  const bf16_t* bp = Bg + (size_t)crow * ldb + ccol;
  const int KT = K >> 6;
  const bf16_t* pa = sA + (wm * 128 + lr) * 64;
  const bf16_t* pb = sB + (wn * NI * 16 + lr) * 64;
#define G_LOAD(RA, RB, K0)                                                                                 \
  {                                                                                                       \
    _Pragma("unroll") for (int i = 0; i < 4; ++i) RA[i] = *(const u32x4*)(ap + (size_t)(64 * i) * lda + (K0)); \
    _Pragma("unroll") for (int i = 0; i < NI; ++i) RB[i] = *(const u32x4*)(bp + (size_t)(64 * i) * ldb + (K0)); \
  }
#define G_STORE(RA, RB, BUF)                                                                               \
  {                                                                                                       \
    _Pragma("unroll") for (int i = 0; i < 4; ++i) *(u32x4*)(sA + (BUF) * 32768 + (crow + 64 * i) * 64 + scol) = RA[i]; \
    _Pragma("unroll") for (int i = 0; i < NI; ++i) *(u32x4*)(sB + (BUF) * 32768 + (crow + 64 * i) * 64 + scol) = RB[i]; \
  }
  if constexpr (DEEP) {
    u32x4 ra0[4], rb0[NI], ra1[4], rb1[NI];
    G_LOAD(ra0, rb0, 0);
    G_LOAD(ra1, rb1, 64);
    G_STORE(ra0, rb0, 0);
    __syncthreads();
    for (int kt = 0; kt < KT; kt += 2) {
      if (kt + 2 < KT) G_LOAD(ra0, rb0, (kt + 2) << 6);
      gemm_compute<NI, TRANS>(acc, pa, pb, lr, lg);
      G_STORE(ra1, rb1, 1);
      __syncthreads();
      if (kt + 3 < KT) G_LOAD(ra1, rb1, (kt + 3) << 6);
      gemm_compute<NI, TRANS>(acc, pa + 32768, pb + 32768, lr, lg);
      if (kt + 2 < KT) G_STORE(ra0, rb0, 0);
      __syncthreads();
    }
  } else {
    u32x4 ra[4], rb[NI];
    G_LOAD(ra, rb, 0);
    G_STORE(ra, rb, 0);
    __syncthreads();
    for (int kt = 0; kt < KT; ++kt) {
      const int buf = kt & 1;
      if (kt + 1 < KT) G_LOAD(ra, rb, (kt + 1) << 6);
      gemm_compute<NI, TRANS>(acc, pa + buf * 32768, pb + buf * 32768, lr, lg);
      if (kt + 1 < KT) G_STORE(ra, rb, buf ^ 1);
      __syncthreads();
    }
  }
#undef G_LOAD
#undef G_STORE
}

DEV bool tile_map(int w, int ntm, int ntn_pad, int sm, int sn, int& tm, int& tn) {
  const int per = sm * sn;
  const int x = w & 7, j = w >> 3;
  const int nsn = ntn_pad / sn;
  const int nsup = (ntm / sm) * nsn;
  const int lo = (x * nsup) >> 3, hi = ((x + 1) * nsup) >> 3;
  const int sup = lo + j / per, within = j % per;
  if (sup >= hi) return false;
  tm = (sup / nsn) * sm + within / sn;
  tn = (sup % nsn) * sn + within % sn;
  return true;
}
DEV int tile_slots(int ntm, int ntn_pad, int sm, int sn) {
  const int nsup = (ntm / sm) * (ntn_pad / sn);
  return ((nsup + 7) / 8) * 8 * sm * sn;
}
DEV int next_slot(int t, int nslots, int ntm, int ntn_pad, int sm, int sn, int& tm, int& tn) {
  while (t < nslots && !tile_map(t, ntm, ntn_pad, sm, sn, tm, tn)) t += gridDim.x;
  return t < nslots ? t : nslots;
}

template <int NI>
DEV void zero_acc(f32x4 (&acc)[NI][8]) {
#pragma unroll
  for (int ni = 0; ni < NI; ++ni)
#pragma unroll
    for (int mi = 0; mi < 8; ++mi) acc[ni][mi] = f32x4{0.f, 0.f, 0.f, 0.f};
}

DEV const float* xin_ptr(const Params& p, int m) {
  return m < NLAT ? p.x + (size_t)m * D : p.ctx + (size_t)(m - NLAT) * D;
}
template <int NI>
DEV void epi_resid(const Params& p, f32x4 (&acc)[NI][8], int m0, int n0, int layer, int slot, float coef) {
  const int tid_ = otid(); const int lane = tid_ & 63, wave = tid_ >> 6, wm = wave >> 2, wn = wave & 3, lr = lane & 15, lg = lane >> 4;
  const float* modv = (const float*)(p.ws + OFF_MOD) + (size_t)layer * 9 * 9216 + slot * 1024;
#pragma unroll
  for (int mi = 0; mi < 8; ++mi) {
    const int m = m0 + wm * 128 + mi * 16 + lr;
    float* xr = xrow_ptr(p, m);
    const float* xs = (layer == 0 && slot == 2) ? xin_ptr(p, m) : xr;
    const float* mv = modv + (size_t)mod_bp(m) * 9216;
#pragma unroll
    for (int ni = 0; ni < NI; ++ni) {
      const int n = n0 + wn * NI * 16 + ni * 16 + lg * 4;
      float4 xv = *(const float4*)(xs + n);
      const float4 g = *(const float4*)(mv + n);
      xv.x += coef * g.x * acc[ni][mi][0];
      xv.y += coef * g.y * acc[ni][mi][1];
      xv.z += coef * g.z * acc[ni][mi][2];
      xv.w += coef * g.w * acc[ni][mi][3];
      *(float4*)(xr + n) = xv;
    }
  }
}

DEV int srccol_map(int mt, int n) {
  if (mt == 0) return n;
  if (mt == 1) { const int qd = n >> 5, r = n & 31; return r < 16 ? 16 * qd + r : FF + 16 * qd + (r - 16); }
  if (mt == 2) return n < 2560 ? n : (n < 3712 ? n + 32 : (n < 3744 ? n - 1152 : (n < 3840 ? -1 : (n < 3968 ? n - 96 : -1))));
  return 3872 + n;
}

DEV void convert_tile(const float* __restrict__ src, int ld, int K, int mt, bf16_t* __restrict__ dst, int tile, unsigned char* smem) {
  const int tid = otid() & 255;
  float* t = (float*)(smem + (otid() >> 8) * 16640);
  const int KT = K >> 6;
  const int kt = tile % KT, nt = tile / KT;
  {
    const int j = tid & 63, i0 = tid >> 6;
    const int sc = srccol_map(mt, nt * 64 + j);
#pragma unroll
    for (int ii = 0; ii < 16; ++ii) {
      const int i = i0 + 4 * ii;
      t[i * 65 + j] = sc >= 0 ? src[(size_t)(kt * 64 + i) * ld + sc] : 0.f;
    }
  }
  __syncthreads();
  {
    const int i = (tid & 7) * 8, j0 = tid >> 3;
#pragma unroll
    for (int jj = 0; jj < 2; ++jj) {
      const int j = j0 + 32 * jj;
      uint4 v;
      v.x = pack2(t[(i + 0) * 65 + j], t[(i + 1) * 65 + j]);
      v.y = pack2(t[(i + 2) * 65 + j], t[(i + 3) * 65 + j]);
      v.z = pack2(t[(i + 4) * 65 + j], t[(i + 5) * 65 + j]);
      v.w = pack2(t[(i + 6) * 65 + j], t[(i + 7) * 65 + j]);
      *(uint4*)(dst + (size_t)(nt * 64 + j) * K + kt * 64 + i) = v;
    }
  }
  __syncthreads();
}

constexpr int CONV_TILES = 6656;
DEV void convert_item(const Params& p, int layer, int t, unsigned char* smem) {
  bf16_t* W = (bf16_t*)(p.ws + OFF_W);
  if (t < 1408) { convert_tile(p.w_ffn1_in + (size_t)layer * D * 2 * FF, 2 * FF, D, 1, W + W_UP1, t, smem); return; }
  t -= 1408;
  if (t < 704) { convert_tile(p.w_ffn1_out + (size_t)layer * FF * D, D, FF, 0, W + W_DN1, t, smem); return; }
  t -= 704;
  if (t < 1408) { convert_tile(p.w_ffn2_in + (size_t)layer * D * 2 * FF, 2 * FF, D, 1, W + W_UP2, t, smem); return; }
  t -= 1408;
  if (t < 704) { convert_tile(p.w_ffn2_out + (size_t)layer * FF * D, D, FF, 0, W + W_DN2, t, smem); return; }
  t -= 704;
  if (t < 1024) { convert_tile(p.w_mix_in + (size_t)layer * D * 6944, 6944, D, 2, W + W_MIX, t, smem); return; }
  t -= 1024;
  if (t < 768) { convert_tile(p.w_mix_in + (size_t)layer * D * 6944, 6944, D, 3, W + W_G, t, smem); return; }
  t -= 768;
  if (t < 128) { convert_tile(p.w_br_a + (size_t)layer * 512 * D, D, 512, 0, W + W_BRA, t, smem); return; }
  t -= 128;
  if (t < 128) { convert_tile(p.w_br_b + (size_t)layer * 512 * D, D, 512, 0, W + W_BRB, t, smem); return; }
  t -= 128;
  if (t < 128) { convert_tile(p.w_br_c + (size_t)layer * 512 * D, D, 512, 0, W + W_BRC, t, smem); return; }
  t -= 128;
  convert_tile(p.w_mix_out + (size_t)layer * D * D, D, D, 0, W + W_OUT, t, smem);
}

DEV void mod_item(const Params& p, int item, unsigned char* smem) {
  float* sc = (float*)smem;
  const int tid = otid();
  const int kp = item & 3, lj = item >> 2;
  const int layer = lj / 18, jb = lj % 18;
  for (int i = tid; i < 9 * 256; i += NTHR) {
    const int bp = i >> 8, k = kp * 256 + (i & 255);
    const float v = bp < 8 ? p.c[bp * 1024 + k] : p.c_ctx[k];
    sc[i] = siluf_(v);
  }
  __syncthreads();
  const int j = jb * NTHR + tid;
  float acc[9];
#pragma unroll
  for (int b = 0; b < 9; ++b) acc[b] = 0.f;
  const float* w = p.w_ada + ((size_t)layer * D + kp * 256) * 9216 + j;
#pragma unroll 2
  for (int k = 0; k < 256; k += 4) {
    const float w0 = w[(size_t)(k + 0) * 9216], w1 = w[(size_t)(k + 1) * 9216], w2 = w[(size_t)(k + 2) * 9216], w3 = w[(size_t)(k + 3) * 9216];
#pragma unroll
    for (int b = 0; b < 9; ++b) {
      const float4 s4 = *(const float4*)(sc + b * 256 + k);
      acc[b] += s4.x * w0 + s4.y * w1 + s4.z * w2 + s4.w * w3;
    }
  }
  float* modv = (float*)(p.ws + OFF_MOD) + (size_t)layer * 9 * 9216;
  const float bb = kp == 0 ? p.b_ada[layer * 9216 + j] : 0.f;
#pragma unroll
  for (int b = 0; b < 9; ++b) atomicAdd(modv + (size_t)b * 9216 + j, acc[b] + bb);
  __syncthreads();
}

DEV void phase_prologue(const Params& p, unsigned char* smem) {
  const int tid = otid();
  const int nitems = 288 + 1;
  for (int it = blockIdx.x; it < nitems; it += gridDim.x) {
    if (it < 288) {
      mod_item(p, it, smem);
    } else if (it == 288) {
      float* rope = (float*)(p.ws + OFF_ROPE);
      for (int i = tid; i < 1024; i += NTHR) {
        const int pos = i >> 4, fi = i & 15;
        const float freq = powf(10000.0f, -(float)fi / 16.0f);
        const float ang = (float)pos * freq;
        rope[i] = cosf(ang);
        rope[1024 + i] = sinf(ang);
      }
      if (tid < DEPTH) {
        const float* lp = p.diff_lambda + tid * 256;
        float s01 = 0.f, s23 = 0.f;
        for (int i = 0; i < 64; ++i) { s01 += lp[i] * lp[64 + i]; s23 += lp[128 + i] * lp[192 + i]; }
        const float lam_init = 0.8f - 0.6f * expf(-0.3f * (float)tid);
        ((float*)(p.ws + OFF_MISC))[tid] = expf(s01) - expf(s23) + lam_init;
        ((int*)(p.ws + OFF_MISC + 64))[tid] = 0;
      }
    } else {
      const int r0 = (it - 289) * 32;
      for (int i = tid; i < 32 * 256; i += NTHR) {
        const int m = r0 + (i >> 8), c4 = (i & 255) * 4;
        const float4 v = m < NLAT ? *(const float4*)(p.x + (size_t)m * D + c4) : *(const float4*)(p.ctx + (size_t)(m - NLAT) * D + c4);
        *(float4*)(xrow_ptr(p, m) + c4) = v;
      }
    }
  }
}

DEV void phase_norm(const Params& p, int layer, int which, bool conv, unsigned char* smem, int nrows) {
  const int tid = otid(), lane = tid & 63, wave = tid >> 6;
  const int nconv = conv ? CONV_TILES / 2 : 0;
  bf16_t* H = (bf16_t*)(p.ws + OFF_H);
  const float* g = p.norm_g + (size_t)(layer * 3 + which) * D;
  for (int it = blockIdx.x; it < nconv; it += gridDim.x) convert_item(p, layer, it * 2 + (tid >> 8), smem);
  {
    const int nw = gridDim.x * 8, rpw = (nrows + nw - 1) / nw;
    const int r0 = (blockIdx.x * 8 + wave) * rpw;
    for (int rr = 0; rr < rpw; ++rr) {
      const int m = r0 + rr;
      if (m >= nrows) break;
      const float* xr = (layer == 0 && which == 0) ? xin_ptr(p, m) : xrow_ptr(p, m);
      const float* mv = (const float*)(p.ws + OFF_MOD) + ((size_t)layer * 9 + mod_bp(m)) * 9216 + (3 * which) * 1024;
      float4 v[4];
      float ss = 0.f;
#pragma unroll
      for (int q = 0; q < 4; ++q) {
        v[q] = *(const float4*)(xr + q * 256 + lane * 4);
        ss += v[q].x * v[q].x + v[q].y * v[q].y + v[q].z * v[q].z + v[q].w * v[q].w;
      }
#pragma unroll
      for (int o = 32; o >= 1; o >>= 1) ss += __shfl_xor(ss, o);
      const float rstd = rsqrtf(ss * (1.f / 1024.f) + 1e-6f);
#pragma unroll
      for (int q = 0; q < 4; ++q) {
        const int cidx = q * 256 + lane * 4;
        const float4 gg = *(const float4*)(g + cidx);
        const float4 sh = *(const float4*)(mv + cidx);
        const float4 sc = *(const float4*)(mv + 1024 + cidx);
        const float a0 = (v[q].x * rstd * gg.x) * (1.f + sc.x) + sh.x;
        const float a1 = (v[q].y * rstd * gg.y) * (1.f + sc.y) + sh.y;
        const float a2 = (v[q].z * rstd * gg.z) * (1.f + sc.z) + sh.z;
        const float a3 = (v[q].w * rstd * gg.w) * (1.f + sc.w) + sh.w;
        uint2 o2; o2.x = pack2(a0, a1); o2.y = pack2(a2, a3);
        *(uint2*)(H + (size_t)m * D + cidx) = o2;
      }
    }
  }
}

DEV void phase_ffn_up(const Params& p, size_t woff, unsigned char* smem, int ntm) {
  const bf16_t* H = (const bf16_t*)(p.ws + OFF_H);
  const bf16_t* W = (const bf16_t*)(p.ws + OFF_W) + woff;
  bf16_t* hid = (bf16_t*)(p.ws + OFF_U);
  const int tid_ = otid(); const int lane = tid_ & 63, wave = tid_ >> 6, wm = wave >> 2, wn = wave & 3, lr = lane & 15, lg = lane >> 4;
  const int nslots = tile_slots(ntm, 22, 8, 2);
  int tm, tn, tm2 = 0, tn2 = 0;
  bool primed = false;
  for (int t = next_slot(blockIdx.x, nslots, ntm, 22, 8, 2, tm, tn); t < nslots;) {
    const int m0 = tm * 256, n0 = tn * 256;
    f32x4 acc[4][8];
    zero_acc<4>(acc);
    gemm_kloop<4, true>(acc, H + (size_t)m0 * D, D, W + (size_t)n0 * D, D, D, smem, primed);
    t = next_slot(t + gridDim.x, nslots, ntm, 22, 8, 2, tm2, tn2);
    primed = t < nslots;
    if (primed) glds64_prime(H + (size_t)tm2 * 256 * D, D, W + (size_t)tn2 * 256 * D, D, smem);
    tm = tm2; tn = tn2;
#pragma unroll
    for (int mi = 0; mi < 8; ++mi) {
      const int m = m0 + wm * 128 + mi * 16 + lr;
#pragma unroll
      for (int q = 0; q < 2; ++q) {
        const int hc = ((n0 + wn * 64) >> 1) + 16 * q + lg * 4;
        float r[4];
#pragma unroll
        for (int i = 0; i < 4; ++i) r[i] = siluf_(acc[2 * q][mi][i]) * acc[2 * q + 1][mi][i];
        uint2 o2; o2.x = pack2(r[0], r[1]); o2.y = pack2(r[2], r[3]);
        *(uint2*)(hid + (size_t)m * FF + hc) = o2;
      }
    }
  }
}

DEV void phase_gemm_resid(const Params& p, const bf16_t* A, int lda, int K, size_t woff, int layer, int slot, float coef, unsigned char* smem, bool tail) {
  const bf16_t* W = (const bf16_t*)(p.ws + OFF_W) + woff;
  const int nslots = tile_slots(128, 4, 8, 4);
  int tm, tn, tm2 = 0, tn2 = 0;
  bool primed = false;
  for (int t = next_slot(blockIdx.x, nslots, 128, 4, 8, 4, tm, tn); t < nslots;) {
    const int m0 = tm * 256, n0 = tn * 256;
    f32x4 acc[4][8];
    zero_acc<4>(acc);
    gemm_kloop<4, true>(acc, A + (size_t)m0 * lda, lda, W + (size_t)n0 * K, K, K, smem, primed);
    t = next_slot(t + gridDim.x, nslots, 128, 4, 8, 4, tm2, tn2);
    primed = t < nslots;
    if (primed) glds64_prime(A + (size_t)tm2 * 256 * lda, lda, W + (size_t)tn2 * 256 * K, K, smem);
    epi_resid<4>(p, acc, m0, n0, layer, slot, coef);
    tm = tm2; tn = tn2;
  }
  if (tail) {
    for (int u = blockIdx.x; u < 128; u += gridDim.x) {
      const int m0 = (128 + (u >> 4)) * 256, n0 = (u & 15) * 64;
      f32x4 acc[1][8];
      zero_acc<1>(acc);
      gemm_kloop<1, true, true>(acc, A + (size_t)m0 * lda, lda, W + (size_t)n0 * K, K, K, smem);
      epi_resid<1>(p, acc, m0, n0, layer, slot, coef);
    }
  }
}

DEV void phase_mix(const Params& p, unsigned char* smem) {
  const bf16_t* H = (const bf16_t*)(p.ws + OFF_H);
  const bf16_t* W = (const bf16_t*)(p.ws + OFF_W) + W_MIX;
  bf16_t* PB = (bf16_t*)(p.ws + OFF_U);
  bf16_t* VtA = (bf16_t*)(p.ws + OFF_VTA);
  bf16_t* VtC = (bf16_t*)(p.ws + OFF_VTC);
  const float* rope = (const float*)(p.ws + OFF_ROPE);
  const int tid_ = otid(); const int lane = tid_ & 63, wave = tid_ >> 6, wm = wave >> 2, wn = wave & 3, lr = lane & 15, lg = lane >> 4;
  const int nslots = tile_slots(136, 16, 8, 4);
  int tm_, tn_, tm2 = 0, tn2 = 0;
  bool primed = false;
#define MIX_ADVANCE()                                                                                       \
  {                                                                                                        \
    t = next_slot(t + gridDim.x, nslots, 136, 16, 8, 4, tm2, tn2);                                         \
    primed = t < nslots;                                                                                   \
    if (primed) glds64_prime(H + (size_t)tm2 * 256 * D, D, W + (size_t)tn2 * 256 * D, D, smem);            \
    tm_ = tm2; tn_ = tn2;                                                                                  \
  }
  for (int t = next_slot(blockIdx.x, nslots, 136, 16, 8, 4, tm_, tn_); t < nslots;) {
    const int tm = tm_, tn = tn_;
    const int m0 = tm * 256, n0 = tn * 256;
    const bool vtile = (tn == 4) || (tn == 5) || (tn == 15);
    f32x4 acc[4][8];
    zero_acc<4>(acc);
    if (vtile) {
      gemm_kloop<4, false>(acc, H + (size_t)m0 * D, D, W + (size_t)n0 * D, D, D, smem, primed);
      MIX_ADVANCE();
      if (tn == 15 && wn >= 2) continue;
#pragma unroll
      for (int mi = 0; mi < 8; ++mi) {
        const int m = m0 + wm * 128 + mi * 16 + lg * 4;
        int b, pos;
        if (m < NLAT) { b = m >> 12; pos = m & 4095; } else { const int mc = m - NLAT; b = mc >> 8; pos = 4096 + (mc & 255); }
#pragma unroll
        for (int ni = 0; ni < 4; ++ni) {
          const int n = n0 + wn * 64 + ni * 16 + lr;
          uint2 o2; o2.x = pack2(acc[ni][mi][0], acc[ni][mi][1]); o2.y = pack2(acc[ni][mi][2], acc[ni][mi][3]);
          if (tn == 15) {
            const int ea = n - 3840, kvh = ea >> 6, e = ea & 63;
            *(uint2*)(VtC + ((size_t)((b * 2 + kvh) * 64 + e)) * KVLEN + pos) = o2;
          } else {
            const int ea = n - 1024, hh = ea >> 7, e = ea & 127;
            *(uint2*)(VtA + ((size_t)((b * 4 + hh) * 128 + e)) * KVLEN + pos) = o2;
          }
        }
      }
    } else {
      gemm_kloop<4, true>(acc, H + (size_t)m0 * D, D, W + (size_t)n0 * D, D, D, smem, primed);
      MIX_ADVANCE();
      const int gcol = tn * 4 + wn;
      if (gcol == 59) continue;
      const bool do_rope = (gcol < 16) || (gcol >= 48 && gcol < 58);
      const float scl = (gcol < 8 || (gcol >= 48 && gcol < 56)) ? 0.125f * 1.44269504089f : 1.f;
      const int delta = gcol < 16 ? 0 : 512;
#pragma unroll
      for (int mi = 0; mi < 8; ++mi) {
        const int m = m0 + wm * 128 + mi * 16 + lr;
        if (do_rope && m < NLAT) {
          int tpos = m & 4095;
          asm volatile("" : "+v"(tpos));
#pragma unroll
          for (int pr = 0; pr < 2; ++pr) {
            const int pp = pr == 0 ? (tpos >> 6) : (tpos & 63);
            const float4 cs = *(const float4*)(rope + pp * 16 + lg * 4);
            const float4 sn = *(const float4*)(rope + 1024 + pp * 16 + lg * 4);
            const float ca[4] = {cs.x, cs.y, cs.z, cs.w}, sa[4] = {sn.x, sn.y, sn.z, sn.w};
#pragma unroll
            for (int i = 0; i < 4; ++i) {
              const float x0 = acc[2 * pr][mi][i], x1 = acc[2 * pr + 1][mi][i];
              acc[2 * pr][mi][i] = x0 * ca[i] - x1 * sa[i];
              acc[2 * pr + 1][mi][i] = x1 * ca[i] + x0 * sa[i];
            }
          }
        }
#pragma unroll
        for (int ni = 0; ni < 4; ++ni) {
          const int n = n0 + wn * 64 + ni * 16 + lg * 4;
          if (gcol == 58 && ni >= 2) continue;
          uint2 o2;
          o2.x = pack2(acc[ni][mi][0] * scl, acc[ni][mi][1] * scl);
          o2.y = pack2(acc[ni][mi][2] * scl, acc[ni][mi][3] * scl);
          if (gcol >= 40 && gcol < 48) *(uint2*)((bf16_t*)(p.ws + OFF_BR) + (size_t)m * 512 + (n - 2560)) = o2;
          else *(uint2*)(PB + (size_t)m * PBW + (n - delta)) = o2;
        }
      }
    }
  }
}

#undef MIX_ADVANCE
DEV void phase_gates(const Params& p, unsigned char* smem, int ntm) {
  const bf16_t* H = (const bf16_t*)(p.ws + OFF_H);
  const bf16_t* W = (const bf16_t*)(p.ws + OFF_W) + W_G;
  bf16_t* G = (bf16_t*)(p.ws + OFF_U);
  const int tid_ = otid(); const int lane = tid_ & 63, wave = tid_ >> 6, wm = wave >> 2, wn = wave & 3, lr = lane & 15, lg = lane >> 4;
  const int nslots = tile_slots(ntm, 12, 8, 4);
  int tm, tn, tm2 = 0, tn2 = 0;
  bool primed = false;
  for (int t = next_slot(blockIdx.x, nslots, ntm, 12, 8, 4, tm, tn); t < nslots;) {
    const int m0 = tm * 256, n0 = tn * 256;
    f32x4 acc[4][8];
    zero_acc<4>(acc);
    gemm_kloop<4, true>(acc, H + (size_t)m0 * D, D, W + (size_t)n0 * D, D, D, smem, primed);
    t = next_slot(t + gridDim.x, nslots, ntm, 12, 8, 4, tm2, tn2);
    primed = t < nslots;
    if (primed) glds64_prime(H + (size_t)tm2 * 256 * D, D, W + (size_t)tn2 * 256 * D, D, smem);
    tm = tm2; tn = tn2;
#pragma unroll
    for (int mi = 0; mi < 8; ++mi) {
      const int m = m0 + wm * 128 + mi * 16 + lr;
#pragma unroll
      for (int ni = 0; ni < 4; ++ni) {
        const int n = n0 + wn * 64 + ni * 16 + lg * 4;
        uint2 o2;
        o2.x = pack2(sigmoidf_(acc[ni][mi][0]), sigmoidf_(acc[ni][mi][1]));
        o2.y = pack2(sigmoidf_(acc[ni][mi][2]), sigmoidf_(acc[ni][mi][3]));
        *(uint2*)(G + (size_t)m * 3072 + n) = o2;
      }
    }
  }
}

DEV void phase_merge(const Params& p, unsigned char* smem, int ntm) {
  const bf16_t* Wb = (const bf16_t*)(p.ws + OFF_W);
  const bf16_t* O = (const bf16_t*)(p.ws + OFF_O);
  const bf16_t* G = (const bf16_t*)(p.ws + OFF_U);
  bf16_t* Y = (bf16_t*)(p.ws + OFF_Y);
  const int tid_ = otid(); const int lane = tid_ & 63, wave = tid_ >> 6, wm = wave >> 2, wn = wave & 3, lr = lane & 15, lg = lane >> 4;
  const int nslots = tile_slots(ntm, 8, 4, 8);
  for (int t = blockIdx.x; t < nslots; t += gridDim.x) {
    int tm, tn;
    if (!tile_map(t, ntm, 8, 4, 8, tm, tn)) continue;
    const int m0 = tm * 256, n0 = tn * 128;
    f32x4 y[2][8];
    zero_acc<2>(y);
#pragma unroll 1
    for (int i = 0; i < 3; ++i) {
      f32x4 acc[2][8];
      zero_acc<2>(acc);
      gemm_kloop<2, true, false>(acc, O + (size_t)m0 * 1536 + i * 512, 1536, Wb + W_BRA + (size_t)i * 524288 + (size_t)n0 * 512, 512, 512, smem);
#pragma unroll
      for (int mi = 0; mi < 8; ++mi) {
        const int m = m0 + wm * 128 + mi * 16 + lr;
#pragma unroll
        for (int ni = 0; ni < 2; ++ni) {
          const int n = n0 + wn * 32 + ni * 16 + lg * 4;
          const uint2 gq = *(const uint2*)(G + (size_t)m * 3072 + i * 1024 + n);
          y[ni][mi][0] += __uint_as_float(gq.x << 16) * acc[ni][mi][0];
          y[ni][mi][1] += __uint_as_float(gq.x & 0xffff0000u) * acc[ni][mi][1];
          y[ni][mi][2] += __uint_as_float(gq.y << 16) * acc[ni][mi][2];
          y[ni][mi][3] += __uint_as_float(gq.y & 0xffff0000u) * acc[ni][mi][3];
        }
      }
    }
#pragma unroll
    for (int mi = 0; mi < 8; ++mi) {
      const int m = m0 + wm * 128 + mi * 16 + lr;
#pragma unroll
      for (int ni = 0; ni < 2; ++ni) {
        const int n = n0 + wn * 32 + ni * 16 + lg * 4;
        uint2 o2; o2.x = pack2(y[ni][mi][0], y[ni][mi][1]); o2.y = pack2(y[ni][mi][2], y[ni][mi][3]);
        *(uint2*)(Y + (size_t)m * D + n) = o2;
      }
    }
  }
}

DEV int key_row(int b, int tp) { return tp < 64 ? b * 4096 + tp * 64 : NLAT + b * 256 + (tp - 64) * 64; }

template <int NMAP, int EF>
DEV void flash_item(unsigned char* smem, const bf16_t* __restrict__ PB, int qrow0, int qcol0, int kcol0,
                    const bf16_t* __restrict__ Vt, int b, int ra0, int ra1, int rb0, int rb1, int win_qpos0,
                    float sinkv, bool use_sink, bf16_t* __restrict__ Oout, int ocol0, float lam, float oscale,
                    const float* __restrict__ subln) {
  bf16_t* sK = (bf16_t*)smem;
  bf16_t* sV = (bf16_t*)(smem + 49152);
  const int tid = otid(), lane = tid & 63, wave = tid >> 6, lr = lane & 15, lg = lane >> 4;
  const int na = ra1 - ra0, nt = na + (rb1 - rb0);
  bf16x8 qf[NMAP][2];
  {
    const bf16_t* qp = PB + (size_t)(qrow0 + wave * 16 + lr) * PBW + qcol0 + lg * 8;
#pragma unroll
    for (int mp = 0; mp < NMAP; ++mp)
#pragma unroll
      for (int ks = 0; ks < 2; ++ks) qf[mp][ks] = *(const bf16x8*)(qp + mp * 64 + ks * 32);
  }
  f32x4 Oa[NMAP][EF];
  float mrun[NMAP], lsum[NMAP];
#pragma unroll
  for (int mp = 0; mp < NMAP; ++mp) {
    mrun[mp] = use_sink ? sinkv : -1e30f;
    lsum[mp] = 0.f;
#pragma unroll
    for (int ef = 0; ef < EF; ++ef) Oa[mp][ef] = f32x4{0.f, 0.f, 0.f, 0.f};
  }
  constexpr int NKC = NMAP, NVC = EF / 4;
  u32x4 rk[NKC], rv[NVC];
  const int crow = tid >> 3, ccol = (tid & 7) * 8;
  const int scol = ((tid & 7) ^ (crow & 7)) * 8;
#define FL_GLOAD(TI)                                                                                          \
  {                                                                                                         \
    const int tpn_ = (TI) < na ? ra0 + (TI) : rb0 + ((TI) - na);                                            \
    const bf16_t* kp_ = PB + (size_t)(key_row(b, tpn_) + crow) * PBW + kcol0 + ccol;                        \
    _Pragma("unroll") for (int mp = 0; mp < NMAP; ++mp)                                                     \
      rk[mp] = *(const u32x4*)(kp_ + mp * 64);                                                              \
    const bf16_t* vp_ = Vt + (size_t)crow * KVLEN + tpn_ * 64 + ccol;                                       \
    _Pragma("unroll") for (int i = 0; i < NVC; ++i) rv[i] = *(const u32x4*)(vp_ + (size_t)(64 * i) * KVLEN); \
  }
#define FL_SSTORE(BUF)                                                                                      \
  {                                                                                                         \
    _Pragma("unroll") for (int mp = 0; mp < NMAP; ++mp)                                                     \
      *(u32x4*)(sK + (((BUF) * 2 + mp) * 64 + crow) * 64 + scol) = rk[mp];                                  \
    _Pragma("unroll") for (int i = 0; i < NVC; ++i)                                                         \
      *(u32x4*)(sV + ((BUF) * 128 + crow + 64 * i) * 72 + ccol) = rv[i];                                    \
  }
  FL_GLOAD(0);
  FL_SSTORE(0);
  __syncthreads();
  bf16x8 pk[NMAP][2];
#pragma unroll
  for (int mp = 0; mp < NMAP; ++mp) { pk[mp][0] = bf16x8{0, 0, 0, 0, 0, 0, 0, 0}; pk[mp][1] = bf16x8{0, 0, 0, 0, 0, 0, 0, 0}; }
#define FL_PV(VBUF)                                                                                          \
  {                                                                                                         \
    _Pragma("unroll") for (int ef = 0; ef < EF; ++ef)                                                       \
      _Pragma("unroll") for (int s2 = 0; s2 < 2; ++s2) {                                                    \
        const bf16_t* vp = sV + ((VBUF) * 128 + ef * 16 + lr) * 72 + s2 * 32 + lg * 4;                      \
        const uint2 v0 = *(const uint2*)vp;                                                                 \
        const uint2 v1 = *(const uint2*)(vp + 16);                                                          \
        const u32x4 cvu = {v0.x, v0.y, v1.x, v1.y};                                                         \
        const bf16x8 cvh = __builtin_bit_cast(bf16x8, cvu);                                                 \
        _Pragma("unroll") for (int mp = 0; mp < NMAP; ++mp) Oa[mp][ef] = mfma16(cvh, pk[mp][s2], Oa[mp][ef]); \
      }                                                                                                     \
  }
  int buf = 0, pbuf = 0;
  for (int ti = 0; ti < nt; ++ti) {
    const int tp = ti < na ? ra0 + ti : rb0 + (ti - na);
    const int nbuf = buf == 2 ? 0 : buf + 1;
    if (ti + 1 < nt) FL_GLOAD(ti + 1);
    f32x4 s[NMAP][4];
#pragma unroll
    for (int mp = 0; mp < NMAP; ++mp)
#pragma unroll
      for (int kf = 0; kf < 4; ++kf) {
        s[mp][kf] = f32x4{0.f, 0.f, 0.f, 0.f};
#pragma unroll
        for (int ks = 0; ks < 2; ++ks) {
          const bf16x8 kfr = *(const bf16x8*)(sK + ((buf * 2 + mp) * 64 + kf * 16 + lr) * 64 + (((ks * 4 + lg) ^ (lr & 7)) * 8));
          s[mp][kf] = mfma16(kfr, qf[mp][ks], s[mp][kf]);
        }
      }
    FL_PV(pbuf);
    bf16x8 pkn[NMAP][2];
    float alpha[NMAP];
#pragma unroll
    for (int mp = 0; mp < NMAP; ++mp) {
      if (win_qpos0 >= 0 && tp < 64) {
        const int qpos = win_qpos0 + wave * 16 + lr;
#pragma unroll
        for (int kf = 0; kf < 4; ++kf)
#pragma unroll
          for (int r = 0; r < 4; ++r) {
            const int dd = tp * 64 + kf * 16 + lg * 4 + r - qpos;
            if (dd > 128 || dd < -128) s[mp][kf][r] = -1e30f;
          }
      }
      float mx = -1e30f;
#pragma unroll
      for (int kf = 0; kf < 4; ++kf)
#pragma unroll
        for (int r = 0; r < 4; ++r) mx = fmaxf(mx, s[mp][kf][r]);
      mx = fmaxf(mx, __shfl_xor(mx, 16));
      mx = fmaxf(mx, __shfl_xor(mx, 32));
      const float mnew = fmaxf(mrun[mp], mx);
      alpha[mp] = __builtin_amdgcn_exp2f(mrun[mp] - mnew);
      mrun[mp] = mnew;
      float ps = 0.f;
#pragma unroll
      for (int kf = 0; kf < 4; ++kf)
#pragma unroll
        for (int r = 0; r < 4; ++r) {
          const float pv = __builtin_amdgcn_exp2f(s[mp][kf][r] - mnew);
          s[mp][kf][r] = pv;
          ps += pv;
        }
      lsum[mp] = lsum[mp] * alpha[mp] + ps;
#pragma unroll
      for (int s2 = 0; s2 < 2; ++s2) {
        bf16x8 t;
#pragma unroll
        for (int r = 0; r < 4; ++r) {
          t[r] = (short)f2bf(s[mp][2 * s2][r]);
          t[4 + r] = (short)f2bf(s[mp][2 * s2 + 1][r]);
        }
        pkn[mp][s2] = t;
      }
    }
#pragma unroll
    for (int mp = 0; mp < NMAP; ++mp) {
#pragma unroll
      for (int ef = 0; ef < EF; ++ef) {
        Oa[mp][ef][0] *= alpha[mp]; Oa[mp][ef][1] *= alpha[mp]; Oa[mp][ef][2] *= alpha[mp]; Oa[mp][ef][3] *= alpha[mp];
      }
#pragma unroll
      for (int s2 = 0; s2 < 2; ++s2) pk[mp][s2] = pkn[mp][s2];
    }
    if (ti + 1 < nt) FL_SSTORE(nbuf);
    __syncthreads();
    pbuf = buf;
    buf = nbuf;
  }
  FL_PV(pbuf);
  __syncthreads();
#undef FL_PV
  float inv[NMAP];
#pragma unroll
  for (int mp = 0; mp < NMAP; ++mp) {
    float lt = lsum[mp];
    lt += __shfl_xor(lt, 16);
    lt += __shfl_xor(lt, 32);
    if (use_sink) lt += __builtin_amdgcn_exp2f(sinkv - mrun[mp]);
    inv[mp] = 1.f / lt;
  }
  bf16_t* op = Oout + (size_t)(qrow0 + wave * 16 + lr) * 1536 + ocol0 + lg * 4;
  if constexpr (NMAP == 2) {
    const float i0 = inv[0], i1 = lam * inv[1];
    float ss = 0.f;
#pragma unroll
    for (int ef = 0; ef < EF; ++ef)
#pragma unroll
      for (int r = 0; r < 4; ++r) {
        const float o = Oa[0][ef][r] * i0 - Oa[1][ef][r] * i1;
        Oa[0][ef][r] = o;
        ss += o * o;
      }
    ss += __shfl_xor(ss, 16);
    ss += __shfl_xor(ss, 32);
    const float rstd = rsqrtf(ss * (1.f / 128.f) + 1e-6f) * oscale;
#pragma unroll
    for (int ef = 0; ef < EF; ++ef) {
      const float4 g = *(const float4*)(subln + ef * 16 + lg * 4);
      uint2 o2;
      o2.x = pack2(Oa[0][ef][0] * rstd * g.x, Oa[0][ef][1] * rstd * g.y);
      o2.y = pack2(Oa[0][ef][2] * rstd * g.z, Oa[0][ef][3] * rstd * g.w);
      *(uint2*)(op + ef * 16) = o2;
    }
  } else {
#pragma unroll
    for (int ef = 0; ef < EF; ++ef) {
      uint2 o2;
      o2.x = pack2(Oa[0][ef][0] * inv[0], Oa[0][ef][1] * inv[0]);
      o2.y = pack2(Oa[0][ef][2] * inv[0], Oa[0][ef][3] * inv[0]);
      *(uint2*)(op + ef * 16) = o2;
    }
  }
}

DEV void gla_item(const Params& p, int layer, int b, int h, int dir, unsigned char* smem) {
  bf16_t* sQe = (bf16_t*)smem;
  bf16_t* sKe = (bf16_t*)(smem + 9216);
  bf16_t* sKdT = (bf16_t*)(smem + 18432);
  bf16_t* sVT = (bf16_t*)(smem + 27648);
  bf16_t* sST = (bf16_t*)(smem + 46080);
  float* sLR = (float*)(smem + 64512);
  float* sTot = (float*)(smem + 68608);
  float* sDec = (float*)(smem + 70656);
  const bf16_t* PB = (const bf16_t*)(p.ws + OFF_U);
  bf16_t* OFB = (bf16_t*)(p.ws + OFF_OFB) + (size_t)dir * MROWS * 512;
  const int tid = otid(), lane = tid & 63, wave = tid >> 6, lr = lane & 15, lg = lane >> 4;
  const int cch = tid & 63, qd = tid >> 6;
  float gwr[16];
#pragma unroll
  for (int r = 0; r < 16; ++r) gwr[r] = p.gla_gate_w[(size_t)((layer * 2 + dir) * 16 + r) * 256 + h * 64 + cch];
  const float gbv = p.gla_gate_b[(layer * 2 + dir) * 256 + h * 64 + cch];
  f32x4 st[4];
#pragma unroll
  for (int c = 0; c < 4; ++c) st[c] = f32x4{0.f, 0.f, 0.f, 0.f};
  for (int i = tid; i < 18432 / 4; i += NTHR) ((unsigned*)sST)[i] = 0u;
  __syncthreads();
  uint2 lrv;
  unsigned qraw[8], kraw[8], vraw[16];
#define GLA_PREFETCH(STEP)                                                                                  \
  {                                                                                                        \
    const int tpn_ = dir == 0 ? ((STEP) < 4 ? 64 + (STEP) : (STEP) - 4) : 67 - (STEP);                      \
    const int rb_ = key_row(b, tpn_);                                                                      \
    if (tid < 256) lrv = *(const uint2*)(PB + (size_t)(rb_ + (tid >> 2)) * PBW + PB_LR + dir * 16 + (tid & 3) * 4); \
    const bf16_t* qp_ = PB + (size_t)(rb_ + qd * 8) * PBW + PB_BQ + h * 64 + cch;                          \
    const bf16_t* kp_ = PB + (size_t)(rb_ + qd * 8) * PBW + PB_BK + h * 64 + cch;                          \
    _Pragma("unroll") for (int pi = 0; pi < 8; ++pi) { qraw[pi] = qp_[(size_t)pi * PBW]; kraw[pi] = kp_[(size_t)pi * PBW]; } \
    const bf16_t* vp_ = PB + (size_t)(rb_ + (tid >> 7) * 16) * PBW + PB_BV + h * 128 + (tid & 127);        \
    _Pragma("unroll") for (int j = 0; j < 16; ++j) vraw[j] = vp_[(size_t)j * PBW];                         \
  }
  GLA_PREFETCH(0);
  for (int step = 0; step < 68; ++step) {
    const int tp = dir == 0 ? (step < 4 ? 64 + step : step - 4) : 67 - step;
    const int rowbase = key_row(b, tp);
    {
      if (tid < 256) {
        const int pp = tid >> 2, r4 = (tid & 3) * 4;
        sLR[pp * 16 + r4 + 0] = bf2f((unsigned short)(lrv.x & 0xffff));
        sLR[pp * 16 + r4 + 1] = bf2f((unsigned short)(lrv.x >> 16));
        sLR[pp * 16 + r4 + 2] = bf2f((unsigned short)(lrv.y & 0xffff));
        sLR[pp * 16 + r4 + 3] = bf2f((unsigned short)(lrv.y >> 16));
      }
      const int e = tid & 127, ph = tid >> 7;
#pragma unroll
      for (int k8 = 0; k8 < 2; ++k8) {
        uint4 o4;
        o4.x = (unsigned)vraw[k8 * 8 + 0] | ((unsigned)vraw[k8 * 8 + 1] << 16);
        o4.y = (unsigned)vraw[k8 * 8 + 2] | ((unsigned)vraw[k8 * 8 + 3] << 16);
        o4.z = (unsigned)vraw[k8 * 8 + 4] | ((unsigned)vraw[k8 * 8 + 5] << 16);
        o4.w = (unsigned)vraw[k8 * 8 + 6] | ((unsigned)vraw[k8 * 8 + 7] << 16);
        *(uint4*)(sVT + e * 72 + ph * 16 + k8 * 8) = o4;
      }
    }
    __syncthreads();
    float cum[8];
    {
      float run = 0.f;
      if (dir == 0) {
#pragma unroll
        for (int pi = 0; pi < 8; ++pi) {
          const float* lrp = sLR + (qd * 8 + pi) * 16;
          float z = gbv;
#pragma unroll
          for (int r = 0; r < 16; ++r) z += lrp[r] * gwr[r];
          const float la = (fminf(z, 0.f) - __logf(1.f + __expf(-fabsf(z)))) * (1.f / 16.f);
          run += la;
          cum[pi] = run;
        }
      } else {
#pragma unroll
        for (int pi = 7; pi >= 0; --pi) {
          const float* lrp = sLR + (qd * 8 + pi) * 16;
          float z = gbv;
#pragma unroll
          for (int r = 0; r < 16; ++r) z += lrp[r] * gwr[r];
          const float la = (fminf(z, 0.f) - __logf(1.f + __expf(-fabsf(z)))) * (1.f / 16.f);
          run += la;
          cum[pi] = run;
        }
      }
      sTot[qd * 64 + cch] = run;
    }
    __syncthreads();
    {
      float last = 0.f, off = 0.f;
#pragma unroll
      for (int q8 = 0; q8 < 8; ++q8) {
        const float tq = sTot[q8 * 64 + cch];
        last += tq;
        if (dir == 0 ? (q8 < qd) : (q8 > qd)) off += tq;
      }
      if (qd == 0) sDec[cch] = __expf(last);
      unsigned short kdp[8];
#pragma unroll
      for (int pi = 0; pi < 8; ++pi) {
        const float cm = cum[pi] + off;
        const float qv = __uint_as_float(qraw[pi] << 16);
        const float kv = __uint_as_float(kraw[pi] << 16);
        sQe[(qd * 8 + pi) * 72 + cch] = f2bf(qv * 0.125f * __expf(cm));
        sKe[(qd * 8 + pi) * 72 + cch] = f2bf(kv * __expf(-cm));
        kdp[pi] = f2bf(kv * __expf(last - cm));
      }
      uint4 o4;
      o4.x = (unsigned)kdp[0] | ((unsigned)kdp[1] << 16);
      o4.y = (unsigned)kdp[2] | ((unsigned)kdp[3] << 16);
      o4.z = (unsigned)kdp[4] | ((unsigned)kdp[5] << 16);
      o4.w = (unsigned)kdp[6] | ((unsigned)kdp[7] << 16);
      *(uint4*)(sKdT + cch * 72 + qd * 8) = o4;
    }
    if (step + 1 < 68) GLA_PREFETCH(step + 1);
    __syncthreads();
#pragma unroll
    for (int iq = 0; iq < 4; ++iq) {
      bf16x8 qfr[2];
#pragma unroll
      for (int ks = 0; ks < 2; ++ks) qfr[ks] = *(const bf16x8*)(sQe + (iq * 16 + lr) * 72 + ks * 32 + lg * 8);
      bf16x8 ap[2];
      bool live[2];
#pragma unroll
      for (int s2 = 0; s2 < 2; ++s2) {
        f32x4 at[2];
        live[s2] = dir == 0 ? (2 * s2 <= iq) : (2 * s2 + 1 >= iq);
#pragma unroll
        for (int jj = 0; jj < 2; ++jj) {
          const int jf = 2 * s2 + jj;
          at[jj] = f32x4{0.f, 0.f, 0.f, 0.f};
          const bool tile_live = dir == 0 ? (jf <= iq) : (jf >= iq);
          if (tile_live) {
#pragma unroll
            for (int ks = 0; ks < 2; ++ks) {
              const bf16x8 kfr = *(const bf16x8*)(sKe + (jf * 16 + lr) * 72 + ks * 32 + lg * 8);
              at[jj] = mfma16(kfr, qfr[ks], at[jj]);
            }
            if (jf == iq) {
              const int ipos = lr;
#pragma unroll
              for (int r = 0; r < 4; ++r) {
                const int jpos = lg * 4 + r;
                const bool keep = dir == 0 ? (ipos >= jpos) : (ipos <= jpos);
                if (!keep) at[jj][r] = 0.f;
              }
            }
          }
        }
        bf16x8 t;
#pragma unroll
        for (int r = 0; r < 4; ++r) { t[r] = (short)f2bf(at[0][r]); t[4 + r] = (short)f2bf(at[1][r]); }
        ap[s2] = t;
      }
      {
        const int erow = wave * 16 + lr;
        f32x4 o = f32x4{0.f, 0.f, 0.f, 0.f};
#pragma unroll
        for (int s2 = 0; s2 < 2; ++s2) {
          if (live[s2]) {
            const bf16_t* vp = sVT + erow * 72 + s2 * 32 + lg * 4;
            const uint2 v0 = *(const uint2*)vp;
            const uint2 v1 = *(const uint2*)(vp + 16);
            const u32x4 cvu = {v0.x, v0.y, v1.x, v1.y};
            o = mfma16(__builtin_bit_cast(bf16x8, cvu), ap[s2], o);
          }
        }
#pragma unroll
        for (int ks = 0; ks < 2; ++ks) {
          const bf16x8 sfr = *(const bf16x8*)(sST + erow * 72 + ks * 32 + lg * 8);
          o = mfma16(sfr, qfr[ks], o);
        }
        uint2 o2; o2.x = pack2(o[0], o[1]); o2.y = pack2(o[2], o[3]);
        *(uint2*)(OFB + (size_t)(rowbase + iq * 16 + lr) * 512 + h * 128 + wave * 16 + lg * 4) = o2;
      }
    }
    {
      const int erow = wave * 16 + lr;
      bf16x8 vfr[2];
#pragma unroll
      for (int ps = 0; ps < 2; ++ps) vfr[ps] = *(const bf16x8*)(sVT + erow * 72 + ps * 32 + lg * 8);
#pragma unroll
      for (int cf = 0; cf < 4; ++cf) {
        const float dc = sDec[cf * 16 + lr];
        f32x4 a = st[cf];
        a[0] *= dc; a[1] *= dc; a[2] *= dc; a[3] *= dc;
#pragma unroll
        for (int ps = 0; ps < 2; ++ps) {
          const bf16x8 kdf = *(const bf16x8*)(sKdT + (cf * 16 + lr) * 72 + ps * 32 + lg * 8);
          a = mfma16(vfr[ps], kdf, a);
        }
        st[cf] = a;
      }
    }
#pragma unroll
    for (int cf = 0; cf < 4; ++cf)
#pragma unroll
      for (int r = 0; r < 4; ++r)
        sST[(wave * 16 + lg * 4 + r) * 72 + cf * 16 + lr] = f2bf(st[cf][r]);
    __syncthreads();
  }
}

#undef GLA_PREFETCH

DEV void phase_mixers(const Params& p, int layer, unsigned char* smem) {
  volatile int* s_itemp = (volatile int*)(smem + LDS_MISC);
  const bf16_t* PB = (const bf16_t*)(p.ws + OFF_U);
  const bf16_t* VtA = (const bf16_t*)(p.ws + OFF_VTA);
  const bf16_t* VtC = (const bf16_t*)(p.ws + OFF_VTC);
  bf16_t* O = (bf16_t*)(p.ws + OFF_O);
  int* ctr = (int*)(p.ws + OFF_MISC + 64) + layer;
  const float lam = ((const float*)(p.ws + OFF_MISC))[layer];
  const float lam_init = 0.8f - 0.6f * expf(-0.3f * (float)layer);
  const int total = 64 + 1024 + 64 + 2048 + 128;
  for (;;) {
    if (otid() == 0) *s_itemp = atomicAdd(ctr, 1);
    __syncthreads();
    int idx = __builtin_amdgcn_readfirstlane(*s_itemp);
    __syncthreads();
    if (idx >= total) break;
    if (idx < 64) {
      gla_item(p, layer, idx >> 3, (idx >> 1) & 3, idx & 1, smem);
      continue;
    }
    idx -= 64;
    if (idx < 1024 + 64) {
      int b, h, qrow0, r0;
      if (idx < 1024) { b = idx >> 7; h = (idx >> 5) & 3; qrow0 = b * 4096 + (idx & 31) * 128; r0 = 0; }
      else { const int j = idx - 1024; b = j >> 3; h = (j >> 1) & 3; qrow0 = NLAT + b * 256 + (j & 1) * 128; r0 = 64; }
      flash_item<2, 8>(smem, PB, qrow0, PB_AQ + h * 128, PB_AK + h * 128, VtA + (size_t)((b * 4 + h) * 128) * KVLEN, b,
                       r0, 68, 0, 0, -1, 0.f, false, O, h * 128, lam, 1.f - lam_init, p.diff_subln + layer * 128);
      continue;
    }
    idx -= 1024 + 64;
    {
      int b, hq, qrow0, lo, hi, r0, r1, win;
      if (idx < 2048) {
        b = idx >> 8; hq = (idx >> 5) & 7; const int qt = idx & 31;
        qrow0 = b * 4096 + qt * 128; lo = 2 * qt - 2 < 0 ? 0 : 2 * qt - 2; hi = 2 * qt + 4 > 64 ? 64 : 2 * qt + 4; r0 = 64; r1 = 68; win = qt * 128;
      } else {
        const int j = idx - 2048; b = j >> 4; hq = (j >> 1) & 7;
        qrow0 = NLAT + b * 256 + (j & 1) * 128; lo = 64; hi = 68; r0 = 0; r1 = 0; win = -1;
      }
      const int kvh = hq >> 2;
      flash_item<1, 4>(smem, PB, qrow0, PB_CQ + hq * 64, PB_CK + kvh * 64, VtC + (size_t)((b * 2 + kvh) * 64) * KVLEN, b,
                       lo, hi, r0, r1, win, p.swa_sink[layer * 8 + hq] * 1.44269504089f, true, O, 1024 + hq * 64, 0.f, 1.f, nullptr);
    }
  }
}

DEV void phase_gla_final(const Params& p, int layer) {
  const int tid = otid(), lane = tid & 63, wave = tid >> 6;
  const bf16_t* PB = (const bf16_t*)(p.ws + OFF_U);
  const bf16_t* OF = (const bf16_t*)(p.ws + OFF_OFB);
  const bf16_t* OB = OF + (size_t)MROWS * 512;
  bf16_t* O = (bf16_t*)(p.ws + OFF_O);
  const float* gn = p.gla_norm + layer * 128;
  const int nitems = MROWS / 32;
  for (int it = blockIdx.x; it < nitems; it += gridDim.x) {
    for (int rr = 0; rr < 4; ++rr) {
      const int m = it * 32 + wave * 4 + rr;
      const uint4 a = *(const uint4*)(OF + (size_t)m * 512 + lane * 8);
      const uint4 bq = *(const uint4*)(OB + (size_t)m * 512 + lane * 8);
      const uint4 rq = *(const uint4*)((const bf16_t*)(p.ws + OFF_BR) + (size_t)m * 512 + lane * 8);
      const unsigned aw[4] = {a.x, a.y, a.z, a.w}, bw[4] = {bq.x, bq.y, bq.z, bq.w}, rw[4] = {rq.x, rq.y, rq.z, rq.w};
      float o[8], rv[8];
      float ss = 0.f;
#pragma unroll
      for (int i = 0; i < 4; ++i) {
        o[2 * i] = bf2f((unsigned short)(aw[i] & 0xffff)) + bf2f((unsigned short)(bw[i] & 0xffff));
        o[2 * i + 1] = bf2f((unsigned short)(aw[i] >> 16)) + bf2f((unsigned short)(bw[i] >> 16));
        rv[2 * i] = bf2f((unsigned short)(rw[i] & 0xffff));
        rv[2 * i + 1] = bf2f((unsigned short)(rw[i] >> 16));
        ss += o[2 * i] * o[2 * i] + o[2 * i + 1] * o[2 * i + 1];
      }
      ss += __shfl_xor(ss, 1); ss += __shfl_xor(ss, 2); ss += __shfl_xor(ss, 4); ss += __shfl_xor(ss, 8);
      const float rstd = rsqrtf(ss * (1.f / 128.f) + 1e-6f);
      const int e0 = (lane & 15) * 8;
      float res[8];
#pragma unroll
      for (int i = 0; i < 8; ++i) res[i] = o[i] * rstd * gn[e0 + i] * siluf_(rv[i]);
      uint4 o4;
      o4.x = pack2(res[0], res[1]); o4.y = pack2(res[2], res[3]); o4.z = pack2(res[4], res[5]); o4.w = pack2(res[6], res[7]);
      *(uint4*)(O + (size_t)m * 1536 + 512 + lane * 8) = o4;
    }
  }
}

DEV void phase_final(const Params& p) {
  const int tid = otid(), lane = tid & 63, wave = tid >> 6;
  const int nitems = NLAT / 32;
  for (int it = blockIdx.x; it < nitems; it += gridDim.x) {
    for (int rr = 0; rr < 4; ++rr) {
      const int m = it * 32 + wave * 4 + rr;
      float* xr = p.out + (size_t)m * D;
      float4 v[4];
      float ss = 0.f;
#pragma unroll
      for (int q = 0; q < 4; ++q) {
        v[q] = *(const float4*)(xr + q * 256 + lane * 4);
        ss += v[q].x * v[q].x + v[q].y * v[q].y + v[q].z * v[q].z + v[q].w * v[q].w;
      }
#pragma unroll
      for (int o = 32; o >= 1; o >>= 1) ss += __shfl_xor(ss, o);
      const float rstd = rsqrtf(ss * (1.f / 1024.f) + 1e-6f);
#pragma unroll
      for (int q = 0; q < 4; ++q) {
        const float4 g = *(const float4*)(p.final_g + q * 256 + lane * 4);
        float4 o4;
        o4.x = v[q].x * rstd * g.x; o4.y = v[q].y * rstd * g.y; o4.z = v[q].z * rstd * g.z; o4.w = v[q].w * rstd * g.w;
        *(float4*)(xr + q * 256 + lane * 4) = o4;
      }
    }
  }
}


#define XB_TMO      128
#define XB_XCNT(j)  (256  + 64 * (j))
#define XB_XSUB(j)  (1280 + 64 * (j))
#define XB_XGEN(j)  (2304 + 64 * (j))
#define XB_TOP      3328
#define XB_TOPGEN   3392
#define XCD_BAR_WORDS 3456
#define XB_SPIN_CAP (1u << 22)
#define LAS __attribute__((address_space(3)))
DEV unsigned xb_ld(unsigned* p) { return __hip_atomic_load(p, __ATOMIC_RELAXED, __HIP_MEMORY_SCOPE_AGENT); }
DEV unsigned xb_add(unsigned* p, unsigned v) { return __hip_atomic_fetch_add(p, v, __ATOMIC_RELAXED, __HIP_MEMORY_SCOPE_AGENT); }
DEV unsigned xb_xcc_id() { return (unsigned)__builtin_amdgcn_s_getreg((3 << 11) | 20) & 0xFu; }
#define XB_SPIN(cond, bar) do { unsigned _sp = 0; while (cond) { __builtin_amdgcn_s_sleep(1); \
    if ((++_sp & 255u) == 0u) { if (xb_ld(&(bar)[XB_TMO])) break; if (_sp > XB_SPIN_CAP) { atomicAdd(&(bar)[XB_TMO], 1u); break; } } } } while (0)
struct XcdBarrier { unsigned* bar; unsigned x; volatile LAS unsigned* st; };
DEV XcdBarrier xcd_barrier_post(unsigned* bar, volatile LAS unsigned* st) {
  XcdBarrier b; b.bar = bar; b.x = xb_xcc_id(); b.st = st;
  if (threadIdx.x == 0) (void)xb_add(&bar[XB_XCNT(b.x)], 1u);
  return b;
}
DEV void xcd_barrier_complete(unsigned* bar, unsigned x, unsigned& nloc, unsigned& nx) {
  const unsigned G = gridDim.x * gridDim.y * gridDim.z;
  unsigned sum, cnt, mine, sp = 0u;
  for (;;) {
    sum = 0u; cnt = 0u; mine = 0u;
#pragma unroll
    for (unsigned j = 0; j < 16; ++j) { const unsigned c = xb_ld(&bar[XB_XCNT(j)]); sum += c; cnt += (c > 0u) ? 1u : 0u; mine = (j == x) ? c : mine; }
    if (sum == G) break;
    __builtin_amdgcn_s_sleep(1);
    if ((++sp & 255u) == 0u) { if (xb_ld(&bar[XB_TMO])) break; if (sp > XB_SPIN_CAP) { atomicAdd(&bar[XB_TMO], 1u); break; } }
  }
  nloc = mine > 0u ? mine : 1u; nx = cnt > 0u ? cnt : 1u;
}
DEV void xcd_barrier(const XcdBarrier& b) {
  asm volatile("s_waitcnt vmcnt(0)" ::: "memory");
  __syncthreads();
  if (threadIdx.x == 0) {
    unsigned* bar = b.bar;
    __builtin_amdgcn_s_waitcnt(0);
    unsigned nloc = b.st[0], nx = b.st[1];
    if (nloc == 0u) { xcd_barrier_complete(bar, b.x, nloc, nx); b.st[0] = nloc; b.st[1] = nx; }
    const unsigned old = xb_add(&bar[XB_XSUB(b.x)], 1u);
    const unsigned gen = old / nloc;
    if (old + 1u == (gen + 1u) * nloc) {
      __builtin_amdgcn_fence(__ATOMIC_RELEASE, "agent");
      asm volatile("s_waitcnt vmcnt(0)" ::: "memory");
      const unsigned og = xb_add(&bar[XB_TOP], 1u);
      const unsigned tg = og / nx;
      if (og + 1u == (tg + 1u) * nx) xb_add(&bar[XB_TOPGEN], 1u);
      else XB_SPIN(xb_ld(&bar[XB_TOPGEN]) == tg, bar);
      __builtin_amdgcn_fence(__ATOMIC_ACQUIRE, "agent");
      xb_add(&bar[XB_XGEN(b.x)], 1u);
      asm volatile("s_waitcnt vmcnt(0)" ::: "memory");
    } else {
      XB_SPIN(xb_ld(&bar[XB_XGEN(b.x)]) == gen, bar);
      __builtin_amdgcn_fence(__ATOMIC_ACQUIRE, "agent");
      asm volatile("s_waitcnt vmcnt(0)" ::: "memory");
    }
  }
  __syncthreads();
}

__global__ void __launch_bounds__(512, 2) mega(Params p) {
  extern __shared__ __attribute__((aligned(16))) unsigned char smem[];
  cg::grid_group grid = cg::this_grid();
  volatile LAS unsigned* xst = (volatile LAS unsigned*)(smem + LDS_MISC + 16);
  if (threadIdx.x == 0) { xst[0] = 0u; xst[1] = 0u; }
  __syncthreads();
  XcdBarrier xb = xcd_barrier_post((unsigned*)(p.ws + OFF_BAR), xst);
  if (p.ph_lo < 0) grid.sync();
  for (int ph = p.ph_lo; ph < p.ph_hi; ++ph) {
    if (ph == 0) {
      phase_prologue(p, smem);
    } else if (ph == NPH - 1) {
      phase_final(p);
    } else {
      const int layer = (ph - 1) / NSUB, sub = (ph - 1) % NSUB;
      const bf16_t* H = (const bf16_t*)(p.ws + OFF_H);
      const bf16_t* U = (const bf16_t*)(p.ws + OFF_U);
      const bf16_t* Yb = (const bf16_t*)(p.ws + OFF_Y);
      const bool last = layer == DEPTH - 1;
      const int ntm_post = last ? 128 : 136;
      switch (sub) {
        case 0: phase_norm(p, layer, 0, true, smem, MROWS); break;
        case 1: phase_ffn_up(p, W_UP1, smem, 136); break;
        case 2: phase_gemm_resid(p, U, FF, FF, W_DN1, layer, 2, 0.5f, smem, true); break;
        case 3: phase_norm(p, layer, 1, false, smem, MROWS); break;
        case 4: phase_mix(p, smem); break;
        case 5: phase_mixers(p, layer, smem); break;
        case 6: phase_gates(p, smem, ntm_post); phase_gla_final(p, layer); break;
        case 7: phase_merge(p, smem, ntm_post); break;
        case 8: phase_gemm_resid(p, Yb, D, D, W_OUT, layer, 5, 1.0f, smem, !last); break;
        case 9: phase_norm(p, layer, 2, false, smem, last ? NLAT : MROWS); break;
        case 10: phase_ffn_up(p, W_UP2, smem, ntm_post); break;
        default: phase_gemm_resid(p, U, FF, FF, W_DN2, layer, 8, 0.5f, smem, !last); break;
      }
      (void)H;
    }
    if (ph + 1 < p.ph_hi) xcd_barrier(xb);
  }
}

extern "C" void kernel_launch(void* const* d_in, const int* in_sizes, int n_in, void* d_out, int out_size, void* d_ws,
                              size_t ws_size, hipStream_t stream) {
  static int grid_blocks = 0;
  if (!grid_blocks) {
    if (ws_size < WS_NEED) fprintf(stderr, "kernel_launch: workspace too small: %zu < %zu\n", ws_size, (size_t)WS_NEED);
    hipFuncSetAttribute((const void*)mega, hipFuncAttributeMaxDynamicSharedMemorySize, LDS_BYTES);
    int dev = 0, cus = 0, per_cu = 0;
    hipGetDevice(&dev);
    hipDeviceGetAttribute(&cus, hipDeviceAttributeMultiprocessorCount, dev);
    hipOccupancyMaxActiveBlocksPerMultiprocessor(&per_cu, (const void*)mega, NTHR, LDS_BYTES);
    if (per_cu > 1) per_cu = 1;
    if (per_cu < 1) per_cu = 1;
    grid_blocks = cus * per_cu;
  }
  Params p{};
  const float** pp = (const float**)&p;
  for (int i = 0; i < 23; ++i) pp[i] = (const float*)d_in[i];
  p.out = (float*)d_out;
  p.ws = (unsigned char*)d_ws;
  p.ph_lo = 0;
  p.ph_hi = NPH;
  void* args[] = {&p};
  (void)hipMemsetAsync((unsigned char*)d_ws + OFF_BAR, 0, 3456 * 4, stream);
  (void)hipMemsetAsync((unsigned char*)d_ws + OFF_MOD, 0, (size_t)DEPTH * 9 * 9216 * 4, stream);
  hipError_t e = hipLaunchCooperativeKernel((const void*)mega, dim3(grid_blocks), dim3(NTHR), args, LDS_BYTES, stream);
  if (e != hipSuccess) fprintf(stderr, "cooperative launch failed: %s (grid %d)\n", hipGetErrorString(e), grid_blocks);
}
```
